# Optimizing an MI355X kernel written in HIP

```python
import math
import numpy as np
import jax
import jax.numpy as jnp
from jax import lax

D_MODEL = 2048
BATCH = 1
SEQ = 8192
DEPTH = 2

GRID_W = 64
CTX_LEN = 256
HEAD_DIM = 128
NA_HEADS = 8
NB_Q_HEADS = 8
NB_KV_HEADS = 2
NA_ROWS = 8
NA_COLS = 16
NA_QCOLS = 16
NA_KCOLS = NA_QCOLS + NA_COLS
SW_RADIUS = 128
SW_BLOCK = 128
ROPE_BASE = 10000.0
SSM_GROUP = 16
SSM_GROUPS = D_MODEL // SSM_GROUP
SSM_STATE = 64
D_FF = -(-8 * D_MODEL // (3 * 256)) * 256
A_WIDTH = NA_HEADS * HEAD_DIM
B_Q_WIDTH = NB_Q_HEADS * HEAD_DIM
B_KV_WIDTH = NB_KV_HEADS * HEAD_DIM
IN_WIDTH = 3 * A_WIDTH + B_Q_WIDTH + 2 * B_KV_WIDTH
MIX_WIDTH = A_WIDTH + B_Q_WIDTH
IN_SPLITS = (A_WIDTH, 2 * A_WIDTH, 3 * A_WIDTH, 3 * A_WIDTH + B_Q_WIDTH, 3 * A_WIDTH + B_Q_WIDTH + B_KV_WIDTH)
EPS = 1e-6
NEG_INF = -1e30

kernel_name = 'hybrid_natten_swa_s5_prefix_dit'


def rms_norm(x, g):
    xf = x.astype(jnp.float32)
    y = xf * lax.rsqrt(jnp.mean(xf * xf, axis=-1, keepdims=True) + EPS)
    return (y * g.astype(jnp.float32)).astype(x.dtype)


def ada_mod(cvec, w, b):
    return jnp.split(jax.nn.silu(cvec) @ w + b, 6, axis=-1)


def swiglu(h, w1, w3, w2):
    return (jax.nn.silu(h @ w1) * (h @ w3)) @ w2


def axial_rope(x, pos_r, pos_c):
    half = x.shape[-1] // 2
    quarter = half // 2
    inv_freq = ROPE_BASE ** (-jnp.arange(quarter, dtype=jnp.float32) / quarter)
    xf = x.astype(jnp.float32)

    def rotate(xa, pos):
        ang = pos[:, None] * inv_freq[None, :]
        cos = jnp.cos(ang)[None, :, None, :]
        sin = jnp.sin(ang)[None, :, None, :]
        x1, x2 = xa[..., :quarter], xa[..., quarter:]
        return jnp.concatenate([x1 * cos - x2 * sin, x2 * cos + x1 * sin], axis=-1)

    return jnp.concatenate([rotate(xf[..., :half], pos_r), rotate(xf[..., half:], pos_c)], axis=-1).astype(x.dtype)


def context_attention(q, k, v, sink):
    b, m, hq, d = q.shape
    hkv = k.shape[2]
    grp = hq // hkv
    qg = q.reshape(b, m, hkv, grp, d)
    s = jnp.einsum('bqhgd,bkhd->bhgqk', qg, k, preferred_element_type=jnp.float32) * (d ** -0.5)
    if sink is not None:
        s_sink = jnp.broadcast_to(sink.astype(jnp.float32).reshape(1, hkv, grp, 1, 1), s.shape[:-1] + (1,))
        s = jnp.concatenate([s, s_sink], axis=-1)
    p = jax.nn.softmax(s, axis=-1)[..., :m].astype(v.dtype)
    return jnp.einsum('bhgqk,bkhd->bqhgd', p, v).reshape(b, m, hq, d)


def neighbourhood_attention(q, k, v, k_ctx, v_ctx, rpb):
    b, seq, h, d = q.shape
    rows = seq // GRID_W
    kh = min(NA_ROWS, rows)
    ncb = GRID_W // NA_QCOLS
    r = jnp.arange(rows)
    key_rows = jnp.clip(r - kh // 2, 0, rows - kh)[:, None] + jnp.arange(kh)[None, :]
    blk = jnp.arange(ncb)
    key_cols = (jnp.clip(blk * NA_QCOLS - NA_COLS // 2, 0, GRID_W - NA_KCOLS)[:, None]
                + jnp.arange(NA_KCOLS)[None, :])
    q_cols = blk[:, None] * NA_QCOLS + jnp.arange(NA_QCOLS)[None, :]
    win_start = jnp.clip(q_cols - NA_COLS // 2, 0, GRID_W - NA_COLS)[..., None]
    kc_b = key_cols[:, None, :]
    col_valid = (kc_b >= win_start) & (kc_b < win_start + NA_COLS)
    row_idx = key_rows - r[:, None] + NA_ROWS - 1
    col_idx = jnp.clip(kc_b - q_cols[..., None] + NA_COLS - 1, 0, 2 * NA_COLS - 2)
    bias = rpb.astype(jnp.float32)[:, row_idx[:, None, None, :, None], col_idx[None, :, :, None, :]]

    gather_r = key_rows[:, None, :, None]
    gather_c = key_cols[None, :, None, :]
    kg = k.reshape(b, rows, GRID_W, h, d)[:, gather_r, gather_c]
    vg = v.reshape(b, rows, GRID_W, h, d)[:, gather_r, gather_c]
    qg = q.reshape(b, rows, ncb, NA_QCOLS, h, d)
    scale = d ** -0.5
    n_loc = kh * NA_KCOLS
    s_loc = jnp.einsum('brnqhd,brnikhd->bhrnqik', qg, kg, preferred_element_type=jnp.float32) * scale + bias[None]
    s_loc = jnp.where(col_valid[:, :, None, :], s_loc, NEG_INF).reshape(b, h, rows, ncb, NA_QCOLS, n_loc)
    s_ctx = jnp.einsum('brnqhd,bmhd->bhrnqm', qg, k_ctx, preferred_element_type=jnp.float32) * scale
    p = jax.nn.softmax(jnp.concatenate([s_loc, s_ctx], axis=-1), axis=-1).astype(v.dtype)
    p_loc = p[..., :n_loc].reshape(b, h, rows, ncb, NA_QCOLS, kh, NA_KCOLS)
    o = (jnp.einsum('bhrnqik,brnikhd->brnqhd', p_loc, vg)
         + jnp.einsum('bhrnqm,bmhd->brnqhd', p[..., n_loc:], v_ctx))
    return o.reshape(b, seq, h, d)


def window_attention(q, k, v, k_ctx, v_ctx, sink):
    b, seq, hq, d = q.shape
    hkv = k.shape[2]
    grp = hq // hkv
    nb = seq // SW_BLOCK
    qb = q.reshape(b, nb, SW_BLOCK, hkv, grp, d)

    def band(t):
        tb = jnp.pad(t, ((0, 0), (SW_BLOCK, SW_BLOCK), (0, 0), (0, 0))).reshape(b, nb + 2, SW_BLOCK, hkv, d)
        return jnp.concatenate([tb[:, :-2], tb[:, 1:-1], tb[:, 2:]], axis=2)

    kb, vb = band(k), band(v)
    blocks = jnp.arange(nb)[:, None]
    q_pos = blocks * SW_BLOCK + jnp.arange(SW_BLOCK)[None, :]
    k_pos = (blocks - 1) * SW_BLOCK + jnp.arange(3 * SW_BLOCK)[None, :]
    k_pos_b = k_pos[:, None, :]
    valid = (jnp.abs(k_pos_b - q_pos[:, :, None]) <= SW_RADIUS) & (k_pos_b >= 0) & (k_pos_b < seq)
    scale = d ** -0.5
    s_loc = jnp.einsum('bnqhgd,bnkhd->bhgnqk', qb, kb, preferred_element_type=jnp.float32) * scale
    s_loc = jnp.where(valid, s_loc, NEG_INF)
    s_ctx = jnp.einsum('bnqhgd,bmhd->bhgnqm', qb, k_ctx, preferred_element_type=jnp.float32) * scale
    s_sink = jnp.broadcast_to(sink.astype(jnp.float32).reshape(1, hkv, grp, 1, 1, 1), s_loc.shape[:-1] + (1,))
    p = jax.nn.softmax(jnp.concatenate([s_loc, s_ctx, s_sink], axis=-1), axis=-1).astype(v.dtype)
    n_loc = 3 * SW_BLOCK
    m = k_ctx.shape[1]
    o = (jnp.einsum('bhgnqk,bnkhd->bnqhgd', p[..., :n_loc], vb)
         + jnp.einsum('bhgnqm,bmhd->bnqhgd', p[..., n_loc:n_loc + m], v_ctx))
    return o.reshape(b, seq, hq, d)


def hybrid_attention(hx, hc, w_in, w_out, rpb, sink, pos_r, pos_c, need_ctx):
    def project(h):
        b, t, _ = h.shape
        parts = jnp.split(h @ w_in, IN_SPLITS, axis=-1)
        return [z.reshape(b, t, -1, HEAD_DIM) for z in parts]

    b, seq, _ = hx.shape
    qa, ka, va, qb, kb, vb = project(hx)
    qa_c, ka_c, va_c, qb_c, kb_c, vb_c = project(hc)
    oa = neighbourhood_attention(qa, ka, va, ka_c, va_c, rpb)
    ob = window_attention(axial_rope(qb, pos_r, pos_c), axial_rope(kb, pos_r, pos_c), vb, kb_c, vb_c, sink)
    yx = jnp.concatenate([oa.reshape(b, seq, A_WIDTH), ob.reshape(b, seq, B_Q_WIDTH)], axis=-1) @ w_out
    if not need_ctx:
        return yx, None
    m = hc.shape[1]
    oa_c = context_attention(qa_c, ka_c, va_c, None)
    ob_c = context_attention(qb_c, kb_c, vb_c, sink)
    yc = jnp.concatenate([oa_c.reshape(b, m, A_WIDTH), ob_c.reshape(b, m, B_Q_WIDTH)], axis=-1) @ w_out
    return yx, yc


def s5_discretise(a_re, a_im, log_dt, b_re, b_im):
    ar = a_re.astype(jnp.float32)
    ai = a_im.astype(jnp.float32)
    dt = jnp.exp(log_dt.astype(jnp.float32))[:, None]
    mag = jnp.exp(ar * dt)
    lam_r, lam_i = mag * jnp.cos(ai * dt), mag * jnp.sin(ai * dt)
    den = ar * ar + ai * ai
    nr = lam_r - 1.0
    coef_r = (nr * ar + lam_i * ai) / den
    coef_i = (lam_i * ar - nr * ai) / den
    br, bi = b_re.astype(jnp.float32), b_im.astype(jnp.float32)
    bbar_r = coef_r[..., None] * br - coef_i[..., None] * bi
    bbar_i = coef_r[..., None] * bi + coef_i[..., None] * br
    return lam_r, lam_i, bbar_r, bbar_i


def complex_diag_scan(lam_r, lam_i, u_r, u_i, reverse):
    a_r = jnp.broadcast_to(lam_r, u_r.shape)
    a_i = jnp.broadcast_to(lam_i, u_i.shape)

    def combine(e1, e2):
        a1r, a1i, b1r, b1i = e1
        a2r, a2i, b2r, b2i = e2
        return (a2r * a1r - a2i * a1i, a2r * a1i + a2i * a1r,
                a2r * b1r - a2i * b1i + b2r, a2r * b1i + a2i * b1r + b2i)

    return lax.associative_scan(combine, (a_r, a_i, u_r, u_i), reverse=reverse, axis=1)


def s5_direction(ux, uc, a_re, a_im, log_dt, b_re, b_im, c_re, c_im, reverse, need_ctx):
    lam_r, lam_i, bbar_r, bbar_i = s5_discretise(a_re, a_im, log_dt, b_re, b_im)
    cr, ci = c_re.astype(jnp.float32), c_im.astype(jnp.float32)

    def drive(u):
        ug = u.astype(jnp.float32).reshape(u.shape[0], u.shape[1], SSM_GROUPS, SSM_GROUP)
        return jnp.einsum('btgh,gph->btgp', ug, bbar_r), jnp.einsum('btgh,gph->btgp', ug, bbar_i)

    def readout(s_r, s_i):
        y = jnp.einsum('btgp,ghp->btgh', s_r, cr) - jnp.einsum('btgp,ghp->btgh', s_i, ci)
        return y.reshape(y.shape[0], y.shape[1], -1)

    uc_r, uc_i = drive(uc)
    _, _, sc_r, sc_i = complex_diag_scan(lam_r, lam_i, uc_r, uc_i, reverse)
    end = 0 if reverse else -1
    s0_r, s0_i = sc_r[:, end][:, None], sc_i[:, end][:, None]
    ux_r, ux_i = drive(ux)
    pw_r, pw_i, sx_r, sx_i = complex_diag_scan(lam_r, lam_i, ux_r, ux_i, reverse)
    sx_r = sx_r + pw_r * s0_r - pw_i * s0_i
    sx_i = sx_i + pw_r * s0_i + pw_i * s0_r
    y_ctx = readout(sc_r, sc_i) if need_ctx else None
    return readout(sx_r, sx_i), y_ctx


def s5_glu_mixer(ux, uc, a_re, a_im, log_dt, b_re, b_im, c_re, c_im, d_skip, w_glu, b_glu, need_ctx):
    d = d_skip.astype(jnp.float32)
    y_x = d * ux.astype(jnp.float32)
    y_c = d * uc.astype(jnp.float32) if need_ctx else None
    for direction in range(2):
        yx_d, yc_d = s5_direction(ux, uc, a_re[direction], a_im[direction], log_dt[direction],
                                  b_re[direction], b_im[direction], c_re[direction], c_im[direction],
                                  direction == 1, need_ctx)
        y_x = y_x + yx_d
        if need_ctx:
            y_c = y_c + yc_d

    def glu(y, dtype):
        z = jax.nn.gelu(y).astype(dtype) @ w_glu + b_glu
        val, gate = jnp.split(z, 2, axis=-1)
        return val * jax.nn.sigmoid(gate)

    return glu(y_x, ux.dtype), (glu(y_c, uc.dtype) if need_ctx else None)


def setup_inputs(seed: int = 0) -> dict:
    key = jax.random.key(seed)
    keys = iter(jax.random.split(key, 32))
    f32 = jnp.float32

    def normal(shape, scale):
        return jax.random.normal(next(keys), shape, f32) * scale

    d, g, h, p = D_MODEL, SSM_GROUPS, SSM_GROUP, SSM_STATE
    n_attn, n_ssm = (DEPTH + 1) // 2, DEPTH // 2
    a_im0 = math.pi * jnp.arange(p, dtype=f32)
    return {
        'x': normal((BATCH, SEQ, d), 1.0),
        'c': normal((BATCH, d), 1.0),
        'ctx': normal((BATCH, CTX_LEN, d), 1.0),
        'c_ctx': normal((d,), 1.0),
        'ada_w': normal((DEPTH, d, 6 * d), 0.5 * d ** -0.5),
        'ada_b': normal((DEPTH, 6 * d), 0.01),
        'norm_mix': 1.0 + normal((DEPTH, d), 0.02),
        'norm_ffn': 1.0 + normal((DEPTH, d), 0.02),
        'ffn_w1': normal((DEPTH, d, D_FF), d ** -0.5),
        'ffn_w3': normal((DEPTH, d, D_FF), d ** -0.5),
        'ffn_w2': normal((DEPTH, D_FF, d), D_FF ** -0.5),
        'attn_w_in': normal((n_attn, d, IN_WIDTH), d ** -0.5),
        'attn_w_out': normal((n_attn, MIX_WIDTH, d), MIX_WIDTH ** -0.5),
        'attn_rpb': normal((n_attn, NA_HEADS, 2 * NA_ROWS - 1, 2 * NA_COLS - 1), 0.02),
        'attn_sink': normal((n_attn, NB_Q_HEADS), 0.5),
        'ssm_a_re': -0.5 + normal((n_ssm, 2, g, p), 0.01),
        'ssm_a_im': a_im0 + normal((n_ssm, 2, g, p), 0.01),
        'ssm_log_dt': jax.random.uniform(next(keys), (n_ssm, 2, g), f32, math.log(1e-3), math.log(1e-1)),
        'ssm_b_re': normal((n_ssm, 2, g, p, h), (2 * h) ** -0.5),
        'ssm_b_im': normal((n_ssm, 2, g, p, h), (2 * h) ** -0.5),
        'ssm_c_re': normal((n_ssm, 2, g, h, p), p ** -0.5),
        'ssm_c_im': normal((n_ssm, 2, g, h, p), p ** -0.5),
        'ssm_d': normal((n_ssm, d), 0.5),
        'ssm_w_glu': normal((n_ssm, d, 2 * d), d ** -0.5),
        'ssm_b_glu': normal((n_ssm, 2 * d), 0.01),
        'norm_final': 1.0 + normal((d,), 0.02),
    }


def reference(x, c, ctx, c_ctx, ada_w, ada_b, norm_mix, norm_ffn, ffn_w1, ffn_w3, ffn_w2,
              attn_w_in, attn_w_out, attn_rpb, attn_sink,
              ssm_a_re, ssm_a_im, ssm_log_dt, ssm_b_re, ssm_b_im, ssm_c_re, ssm_c_im,
              ssm_d, ssm_w_glu, ssm_b_glu, norm_final):
    seq = x.shape[1]
    t = jnp.arange(seq)
    pos_r = (t // GRID_W).astype(jnp.float32)
    pos_c = (t % GRID_W).astype(jnp.float32)
    for layer in range(DEPTH):
        need_ctx = layer < DEPTH - 1
        i = layer // 2
        sh1, sc1, g1, sh2, sc2, g2 = [m[:, None, :] for m in ada_mod(c, ada_w[layer], ada_b[layer])]
        csh1, csc1, cg1, csh2, csc2, cg2 = ada_mod(c_ctx, ada_w[layer], ada_b[layer])
        hx = rms_norm(x, norm_mix[layer]) * (1.0 + sc1) + sh1
        hc = rms_norm(ctx, norm_mix[layer]) * (1.0 + csc1) + csh1
        if layer % 2 == 0:
            yx, yc = hybrid_attention(hx, hc, attn_w_in[i], attn_w_out[i], attn_rpb[i], attn_sink[i],
                                      pos_r, pos_c, need_ctx)
        else:
            yx, yc = s5_glu_mixer(hx, hc, ssm_a_re[i], ssm_a_im[i], ssm_log_dt[i], ssm_b_re[i], ssm_b_im[i],
                                  ssm_c_re[i], ssm_c_im[i], ssm_d[i], ssm_w_glu[i], ssm_b_glu[i], need_ctx)
        x = x + g1 * yx
        x = x + g2 * swiglu(rms_norm(x, norm_ffn[layer]) * (1.0 + sc2) + sh2,
                            ffn_w1[layer], ffn_w3[layer], ffn_w2[layer])
        if need_ctx:
            ctx = ctx + cg1 * yc
            ctx = ctx + cg2 * swiglu(rms_norm(ctx, norm_ffn[layer]) * (1.0 + csc2) + csh2,
                                     ffn_w1[layer], ffn_w3[layer], ffn_w2[layer])
    return rms_norm(x, norm_final)
```

```cpp
#include <hip/hip_runtime.h>
#include <hip/hip_cooperative_groups.h>
#include <cstdio>
namespace cg = cooperative_groups;

#define LAS __attribute__((address_space(3)))
typedef unsigned short bf16_t;
typedef short bf16x8 __attribute__((ext_vector_type(8)));
typedef float f32x4 __attribute__((ext_vector_type(4)));
typedef float f32x16 __attribute__((ext_vector_type(16)));
typedef unsigned u32x4 __attribute__((ext_vector_type(4)));
typedef unsigned u32x2 __attribute__((ext_vector_type(2)));

constexpr int DM = 2048, SEQ = 8192, CTXL = 256, MROWS = SEQ + CTXL, DFF = 5632;
constexpr int NQK = 3328, NV = 1280;
constexpr int SEG_TILES = 33, SEG_STEPS = SEG_TILES * 32;

constexpr size_t OFF_MOD  = 0;
constexpr size_t OFF_ROPE = OFF_MOD + 196608;
constexpr size_t OFF_LAM  = OFF_ROPE + 32768;
constexpr size_t OFF_LAML = OFF_LAM + 131072;
constexpr size_t OFF_BBT  = OFF_LAML + 131072;
constexpr size_t OFF_CCM  = OFF_BBT + 1048576;
constexpr size_t OFF_SEG  = OFF_CCM + 1048576;
constexpr size_t OFF_WQK  = OFF_SEG + 1048576;
constexpr size_t OFF_WV   = OFF_WQK + (size_t)NQK * DM * 2;
constexpr size_t OFF_WO   = OFF_WV + (size_t)NV * DM * 2;
constexpr size_t OFF_W13  = OFF_WO + (size_t)DM * DM * 2;
constexpr size_t OFF_W2   = OFF_W13 + (size_t)2 * 2 * DFF * DM * 2;
constexpr size_t OFF_WGLU = OFF_W2 + (size_t)2 * DM * DFF * 2;
constexpr size_t OFF_H    = OFF_WGLU + (size_t)4096 * DM * 2;
constexpr size_t OFF_QK   = OFF_H + (size_t)MROWS * DM * 2;
constexpr size_t OFF_VT   = OFF_QK + (size_t)MROWS * NQK * 2;
constexpr size_t OFF_O    = OFF_VT + (size_t)NV * MROWS * 2;
constexpr size_t OFF_XA   = OFF_O + (size_t)MROWS * DM * 2;
constexpr size_t OFF_XB   = OFF_XA + (size_t)MROWS * DM * 4;
constexpr size_t OFF_U    = OFF_XB + (size_t)MROWS * DM * 4;
constexpr size_t OFF_YB   = OFF_U + (size_t)MROWS * DFF * 2;
constexpr size_t OFF_BAR  = OFF_YB + (size_t)SEQ * DM * 4;
constexpr size_t BAR_BYTES = 16384;
constexpr size_t OFF_LAMPOW = OFF_BAR + BAR_BYTES;
constexpr size_t OFF_LAM32 = OFF_LAMPOW + (size_t)16384 * 32 * 8;
constexpr size_t WS_END   = OFF_LAM32 + 131072;
constexpr size_t OFF_YF   = OFF_QK;
constexpr size_t OFF_AG   = OFF_O;
constexpr size_t OFF_SSP  = OFF_YB + (size_t)48 * 1024 * 1024;
constexpr size_t OFF_PART = OFF_YB;
static_assert((size_t)SEQ * DM * 4 <= (size_t)MROWS * NQK * 2 + (size_t)NV * MROWS * 2, "YF alias");

struct Params {
    const float* x; const float* c; const float* ctx; const float* c_ctx; const float* ada_w; const float* ada_b;
    const float* norm_mix; const float* norm_ffn; const float* w1; const float* w3; const float* w2;
    const float* w_in; const float* w_out; const float* rpb; const float* sink;
    const float* a_re; const float* a_im; const float* log_dt; const float* b_re; const float* b_im; const float* c_re; const float* c_im;
    const float* ssm_d; const float* w_glu; const float* b_glu; const float* norm_final;
    float* out; unsigned char* ws;
};

__device__ __forceinline__ unsigned cvt_pk_bf16(float lo, float hi) { unsigned r; asm volatile("v_cvt_pk_bf16_f32 %0, %1, %2" : "=v"(r) : "v"(lo), "v"(hi)); return r; }
__device__ __forceinline__ float bf16_lo(unsigned u) { return __uint_as_float(u << 16); }
__device__ __forceinline__ float bf16_hi(unsigned u) { return __uint_as_float(u & 0xffff0000u); }
__device__ __forceinline__ float wave_sum(float v) {
#pragma unroll
    for (int o = 32; o >= 1; o >>= 1) v += __shfl_xor(v, o);
    return v;
}


#define XB_TMO      128
#define XB_XCNT(j)  (256  + 64 * (j))
#define XB_XSUB(j)  (1280 + 64 * (j))
#define XB_XGEN(j)  (2304 + 64 * (j))
#define XB_TOP      3328
#define XB_TOPGEN   3392
#define XCD_BAR_WORDS 3456
#define XB_SPIN_CAP (1u << 18)
__device__ __forceinline__ unsigned xb_ld(unsigned* p)              { return __hip_atomic_load(p, __ATOMIC_RELAXED, __HIP_MEMORY_SCOPE_AGENT); }
__device__ __forceinline__ unsigned xb_add(unsigned* p, unsigned v) { return __hip_atomic_fetch_add(p, v, __ATOMIC_RELAXED, __HIP_MEMORY_SCOPE_AGENT); }
__device__ __forceinline__ unsigned xb_xcc_id() { return (unsigned)__builtin_amdgcn_s_getreg((3 << 11) | 20) & 0xFu; }
#define XB_SPIN(cond, bar) do { unsigned _sp = 0; while (cond) { __builtin_amdgcn_s_sleep(1); \
    if ((++_sp & 255u) == 0u) { if (xb_ld(&(bar)[XB_TMO])) break; if (_sp > XB_SPIN_CAP) { atomicAdd(&(bar)[XB_TMO], 1u); break; } } } } while (0)
struct XcdBarrier { unsigned* bar; unsigned x; volatile LAS unsigned* st; };
__device__ __forceinline__ XcdBarrier xcd_barrier_post(unsigned* bar, volatile LAS unsigned* st) {
    XcdBarrier b; b.bar = bar; b.x = xb_xcc_id(); b.st = st;
    if (threadIdx.x == 0) (void)xb_add(&bar[XB_XCNT(b.x)], 1u);
    return b;
}
__device__ __forceinline__ void xcd_barrier_complete(unsigned* bar, unsigned x, unsigned& nloc, unsigned& nx) {
    const unsigned G = gridDim.x * gridDim.y * gridDim.z;
    unsigned sum, cnt, mine, sp = 0u;
    for (;;) {
        sum = 0u; cnt = 0u; mine = 0u;
#pragma unroll
        for (unsigned j = 0; j < 16; ++j) { const unsigned c = xb_ld(&bar[XB_XCNT(j)]); sum += c; cnt += (c > 0u) ? 1u : 0u; mine = (j == x) ? c : mine; }
        if (sum == G) break;
        __builtin_amdgcn_s_sleep(1);
        if ((++sp & 255u) == 0u) { if (xb_ld(&bar[XB_TMO])) break; if (sp > XB_SPIN_CAP) { atomicAdd(&bar[XB_TMO], 1u); break; } }
    }
    nloc = mine > 0u ? mine : 1u; nx = cnt > 0u ? cnt : 1u;
}
__device__ __forceinline__ void xcd_barrier(const XcdBarrier& b) {
    asm volatile("s_waitcnt vmcnt(0)" ::: "memory");
    __syncthreads();
    if (threadIdx.x == 0) {
        unsigned* bar = b.bar;
        __builtin_amdgcn_s_waitcnt(0);
        unsigned nloc = b.st[0], nx = b.st[1];
        if (nloc == 0u) { xcd_barrier_complete(bar, b.x, nloc, nx); b.st[0] = nloc; b.st[1] = nx; }
        const unsigned old = xb_add(&bar[XB_XSUB(b.x)], 1u);
        const unsigned gen = old / nloc;
        if (old + 1u == (gen + 1u) * nloc) {
            __builtin_amdgcn_fence(__ATOMIC_RELEASE, "agent");
            asm volatile("s_waitcnt vmcnt(0)" ::: "memory");
            const unsigned og = xb_add(&bar[XB_TOP], 1u);
            const unsigned tg = og / nx;
            if (og + 1u == (tg + 1u) * nx) xb_add(&bar[XB_TOPGEN], 1u);
            else XB_SPIN(xb_ld(&bar[XB_TOPGEN]) == tg, bar);
            __builtin_amdgcn_fence(__ATOMIC_ACQUIRE, "agent");
            xb_add(&bar[XB_XGEN(b.x)], 1u);
            asm volatile("s_waitcnt vmcnt(0)" ::: "memory");
        } else {
            XB_SPIN(xb_ld(&bar[XB_XGEN(b.x)]) == gen, bar);
            __builtin_amdgcn_fence(__ATOMIC_ACQUIRE, "agent");
            asm volatile("s_waitcnt vmcnt(0)" ::: "memory");
        }
    }
    __syncthreads();
}

namespace pg8 {
constexpr int BM = 256, BK = 64, HALF = 128, HTB = HALF * BK * 2, STAGE_BYTES = 8 * HTB, NXCD = 8, WGM = 8;
__host__ __device__ __forceinline__ int lds_byte(int r, int c) { const int st = (r >> 4) * 2 + (c >> 5), rr = r & 15, cc = c & 31, ob = rr * 64 + cc * 2; return st * 1024 + (ob ^ (((ob >> 9) & 1) << 5)); }
__host__ __device__ __forceinline__ void stage_rc(int b, int& R, int& C) { const int st = b / 1024, sb = b % 1024, swz = sb ^ (((sb >> 9) & 1) << 5); R = (st >> 1) * 16 + swz / 64; C = (st & 1) * 32 + (swz % 64) / 2; }
struct Unit { int pm, pn, kt0, nt, split, half; };
struct Gemm { const bf16_t* A; const bf16_t* Bt; int M, N, K; };
struct StaticOrder {
    int nM, nN, nwg, G, c, ntk, lim;
    __device__ void init(int M, int N, int K, int G_, int c_) { nM = M / BM; nN = N / BM; nwg = nM * nN; G = G_; c = c_; ntk = K / BK; lim = nwg; }
    __device__ bool next(int i, Unit& u) const { const long L = (long)i * G + c; if (L >= lim) return false; map((int)L, u); return true; }
    __device__ void map(int L, Unit& u) const {
        u.kt0 = 0; u.nt = ntk; u.split = 0; u.half = 0;
        int wgid = L; { const int q = nwg / NXCD, r = nwg % NXCD, xcd = wgid % NXCD, off = wgid / NXCD; wgid = (xcd < r ? xcd * (q + 1) : r * (q + 1) + (xcd - r) * q) + off; }
        const int nig = WGM * nN, gid = wgid / nig, fm = gid * WGM, gsz = (nM - fm) < WGM ? (nM - fm) : WGM;
        u.pm = fm + ((wgid % nig) % gsz); u.pn = (wgid % nig) / gsz;
    }
};
struct OneUnit {
    StaticOrder so; int L, half;
    __device__ bool next(int i, Unit& u) const { if (i != 0 || L < 0) return false; so.map(L, u); u.half = half; return true; }
};
struct CtxSplitOrder {
    StaticOrder so; int nsplit;
    __device__ void init(int N, int K, int G_, int c_) { so.init(8192, N, K, G_, c_); nsplit = (K / BK) / 4; }
    __device__ bool next(int i, Unit& u) const {
        const bool has_piece = so.c < so.nN * nsplit;
        if (has_piece && i == 0) { u.pm = 0; u.pn = so.c % so.nN; u.kt0 = (so.c / so.nN) * 4; u.nt = 4; u.split = 1; u.half = 0; return true; }
        if (i != (has_piece ? 1 : 0)) return false;
        if (!so.next(0, u)) return false;
        u.pm += 1; return true;
    }
};

template <class Epi, class Sched, bool ALIGN_EPI = false, bool SP2 = false, int HPART = 0>
__device__ __forceinline__ void gemm_phase(LAS unsigned char* lds, const Gemm g, const Sched& S, const Epi& E) {
    int tid = threadIdx.x; asm volatile("" : "+v"(tid));
    const int wid = __builtin_amdgcn_readfirstlane(tid >> 6), lane = tid & 63, wr = wid >> 2, wc = wid & 3, fr = lane & 15, fq = lane >> 4;
    const int K = g.K;
    unsigned voffA[2];
#pragma unroll
    for (int i = 0; i < 2; ++i) { int R, C; stage_rc(tid * 16 + i * 8192, R, C); voffA[i] = (unsigned)(R * K + C) * 2u; }
    const size_t kstep = (size_t)(BK * 2);
    const size_t hstep = (size_t)HALF * K * 2;
    const size_t tstep = 2 * hstep;
    const unsigned ldsw = (unsigned)wid * 1024u;
    const int aoff = lds_byte(wr * 64 + fr, fq * 8), boff = lds_byte(wc * 32 + fr, fq * 8);
#define PG8_SA(b, h) (((b) * 2 + (h)) * HTB)
#define PG8_SB(b, h) ((4 + (b) * 2 + (h)) * HTB)
#define PG8_STAGE(bufoff, gbase) do { _Pragma("unroll") for (int _i = 0; _i < 2; ++_i) \
        __builtin_amdgcn_global_load_lds((const unsigned*)((const char*)(gbase) + voffA[_i]), (LAS unsigned*)(lds + (bufoff) + ldsw + _i * 8192), 16, 0, 0); } while (0)
#define PG8_LDA(dst, b, h) do { _Pragma("unroll") for (int m = 0; m < 4; ++m) _Pragma("unroll") for (int k = 0; k < 2; ++k) dst[m][k] = *(const LAS bf16x8*)(lds + PG8_SA(b, h) + aoff + m * 2048 + k * 1024); } while (0)
#define PG8_LDB(dst, b, h) do { _Pragma("unroll") for (int n = 0; n < 2; ++n) _Pragma("unroll") for (int k = 0; k < 2; ++k) dst[n][k] = *(const LAS bf16x8*)(lds + PG8_SB(b, h) + boff + n * 2048 + k * 1024); } while (0)
#define PG8_MMA(ai, bj, At, Bt) do { __builtin_amdgcn_s_setprio(1); _Pragma("unroll") for (int m = 0; m < 4; ++m) _Pragma("unroll") for (int n = 0; n < 2; ++n) _Pragma("unroll") for (int k = 0; k < 2; ++k) \
        acc[ai][bj][m][n] = __builtin_amdgcn_mfma_f32_16x16x32_bf16(Bt[n][k], At[m][k], acc[ai][bj][m][n], 0, 0, 0); __builtin_amdgcn_s_setprio(0); } while (0)
#define PG8_WAIT_V(n) asm volatile("s_waitcnt vmcnt(" #n ")" ::: "memory")
#define PG8_WAIT_L(n) asm volatile("s_waitcnt lgkmcnt(" #n ")" ::: "memory")
#define PG8_BAR __builtin_amdgcn_s_barrier()
#define PG8_SCHED __builtin_amdgcn_sched_barrier(0)
    Unit cur, nxt; int ui = 0;
    if (!S.next(0, cur)) return;
    f32x4 acc[2][2][4][2];
#pragma unroll
    for (int a = 0; a < 2; ++a)
#pragma unroll
        for (int b = 0; b < 2; ++b)
#pragma unroll
            for (int m = 0; m < 4; ++m)
#pragma unroll
                for (int n = 0; n < 2; ++n) acc[a][b][m][n] = (f32x4){0.f, 0.f, 0.f, 0.f};
    bf16x8 At[4][2], B0[2][2], B1[2][2];
    const char* cA = (const char*)g.A + (size_t)cur.pm * tstep + (size_t)cur.kt0 * kstep; const char* cB = (const char*)g.Bt + (size_t)cur.pn * tstep + (size_t)cur.kt0 * kstep;
    if constexpr (SP2) {
        PG8_STAGE(PG8_SB(0, 0), cB); PG8_STAGE(PG8_SB(0, 1), cB + hstep); PG8_STAGE(PG8_SA(0, 0), cA); PG8_STAGE(PG8_SA(0, 1), cA + hstep);
        if (wr == 1) PG8_BAR;
        PG8_WAIT_V(2); PG8_BAR;
        PG8_STAGE(PG8_SB(1, 0), cB + kstep); PG8_STAGE(PG8_SA(1, 0), cA + kstep); PG8_STAGE(PG8_SB(1, 1), cB + hstep + kstep);
        PG8_WAIT_V(6); PG8_BAR;
    } else {
        PG8_STAGE(PG8_SB(0, 0), cB); PG8_STAGE(PG8_SA(0, 0), cA); PG8_STAGE(PG8_SB(0, 1), cB + hstep); PG8_STAGE(PG8_SA(0, 1), cA + hstep);
        if (wr == 1) PG8_BAR;
        PG8_WAIT_V(4); PG8_BAR;
        PG8_STAGE(PG8_SB(1, 0), cB + kstep); PG8_STAGE(PG8_SA(1, 0), cA + kstep); PG8_STAGE(PG8_SB(1, 1), cB + hstep + kstep);
        PG8_WAIT_V(6); PG8_BAR;
    }
    for (;;) {
        const bool has_next = S.next(ui + 1, nxt);
        const char* nA = has_next ? (const char*)g.A + (size_t)nxt.pm * tstep + (size_t)nxt.kt0 * kstep : cA; const char* nB = has_next ? (const char*)g.Bt + (size_t)nxt.pn * tstep + (size_t)nxt.kt0 * kstep : cB;
        const int nt = cur.nt;
        for (int t = 0; t < nt; t += 2) {
            const bool last = (t == nt - 2);
            const char* a1 = cA + (size_t)(t + 1) * kstep;
            const char* a2 = last ? nA : cA + (size_t)(t + 2) * kstep; const char* b2 = last ? nB : cB + (size_t)(t + 2) * kstep;
            const char* a3 = a2 + kstep; const char* b3 = b2 + kstep;
            if constexpr (SP2) {
            PG8_LDB(B0, 0, 0); PG8_LDB(B1, 0, 1); PG8_SCHED; PG8_LDA(At, 0, 0); PG8_STAGE(PG8_SA(1, 1), a1 + hstep);
            PG8_WAIT_V(8); PG8_WAIT_L(0); PG8_BAR; if constexpr (HPART != 2) { PG8_MMA(0, 0, At, B0); PG8_MMA(0, 1, At, B1); } PG8_BAR; PG8_SCHED;
            PG8_LDA(At, 0, 1); PG8_STAGE(PG8_SB(0, 0), b2); PG8_STAGE(PG8_SB(0, 1), b2 + hstep); PG8_STAGE(PG8_SA(0, 0), a2);
            PG8_WAIT_V(8); PG8_WAIT_L(0); PG8_BAR; if constexpr (HPART != 1) { PG8_MMA(1, 0, At, B0); PG8_MMA(1, 1, At, B1); } PG8_BAR; PG8_SCHED;
            PG8_LDB(B0, 1, 0); PG8_LDB(B1, 1, 1); PG8_SCHED; PG8_LDA(At, 1, 0); PG8_STAGE(PG8_SA(0, 1), a2 + hstep);
            PG8_WAIT_V(8); PG8_WAIT_L(0); PG8_BAR; if constexpr (HPART != 2) { PG8_MMA(0, 0, At, B0); PG8_MMA(0, 1, At, B1); } PG8_BAR; PG8_SCHED;
            PG8_LDA(At, 1, 1); PG8_STAGE(PG8_SB(1, 0), b3); PG8_STAGE(PG8_SB(1, 1), b3 + hstep); PG8_STAGE(PG8_SA(1, 0), a3);
            PG8_WAIT_V(8); PG8_WAIT_L(0); PG8_BAR; if constexpr (HPART != 1) { PG8_MMA(1, 0, At, B0); PG8_MMA(1, 1, At, B1); } PG8_BAR; PG8_SCHED;
            } else {
            PG8_LDB(B0, 0, 0); PG8_SCHED; PG8_LDA(At, 0, 0); PG8_STAGE(PG8_SA(1, 1), a1 + hstep);
            PG8_WAIT_L(8); PG8_BAR; PG8_WAIT_L(0); PG8_MMA(0, 0, At, B0); PG8_BAR; PG8_SCHED;
            PG8_LDB(B1, 0, 1); PG8_STAGE(PG8_SB(0, 0), b2);
            PG8_BAR; PG8_WAIT_L(0); PG8_MMA(0, 1, At, B1); PG8_BAR;
            PG8_LDA(At, 0, 1); PG8_STAGE(PG8_SA(0, 0), a2);
            PG8_BAR; PG8_WAIT_L(0); PG8_MMA(1, 0, At, B0); PG8_BAR; PG8_SCHED;
            PG8_STAGE(PG8_SB(0, 1), b2 + hstep);
            PG8_WAIT_V(6); PG8_BAR; PG8_MMA(1, 1, At, B1); PG8_BAR;
            PG8_LDB(B0, 1, 0); PG8_SCHED; PG8_LDA(At, 1, 0); PG8_STAGE(PG8_SA(0, 1), a2 + hstep);
            PG8_WAIT_L(8); PG8_BAR; PG8_WAIT_L(0); PG8_MMA(0, 0, At, B0); PG8_BAR; PG8_SCHED;
            PG8_LDB(B1, 1, 1); PG8_STAGE(PG8_SB(1, 0), b3);
            PG8_BAR; PG8_WAIT_L(0); PG8_MMA(0, 1, At, B1); PG8_BAR;
            PG8_LDA(At, 1, 1); PG8_STAGE(PG8_SA(1, 0), a3);
            PG8_BAR; PG8_WAIT_L(0); PG8_MMA(1, 0, At, B0); PG8_BAR; PG8_SCHED;
            PG8_STAGE(PG8_SB(1, 1), b3 + hstep);
            PG8_WAIT_V(6); PG8_BAR; PG8_MMA(1, 1, At, B1); PG8_BAR;
            }
        }
        if constexpr (ALIGN_EPI) { if (wr == 0) PG8_BAR; }
        if constexpr (!Epi::AFTER_DRAIN) E(acc, cur, wr, wc, fr, fq); else { if (cur.split) E(acc, cur, wr, wc, fr, fq); }
        if (!has_next) break;
#pragma unroll
        for (int a = 0; a < 2; ++a)
#pragma unroll
            for (int b = 0; b < 2; ++b)
#pragma unroll
                for (int m = 0; m < 4; ++m)
#pragma unroll
                    for (int n = 0; n < 2; ++n) acc[a][b][m][n] = (f32x4){0.f, 0.f, 0.f, 0.f};
        cur = nxt; cA = nA; cB = nB; ++ui;
        if constexpr (ALIGN_EPI) { if (wr == 1) PG8_BAR; }
    }
    PG8_WAIT_V(0);
    if constexpr (!ALIGN_EPI) { if (wr == 0) PG8_BAR; }
    PG8_BAR;
    if constexpr (Epi::AFTER_DRAIN) E.fused(acc, cur, wr, wc, fr, fq, lds);
#undef PG8_SA
#undef PG8_SB
#undef PG8_STAGE
#undef PG8_LDA
#undef PG8_LDB
#undef PG8_MMA
#undef PG8_WAIT_V
#undef PG8_WAIT_L
#undef PG8_BAR
#undef PG8_SCHED
}
}

typedef const f32x4 (&AccRef)[2][2][4][2];

struct EpiQK {
    static constexpr bool AFTER_DRAIN = false;
    bf16_t* QK; const float2* rope;
    __device__ __forceinline__ void operator()(AccRef acc, const pg8::Unit& u, int wr, int wc, int fr, int fq) const {
#pragma unroll
        for (int ai = 0; ai < 2; ++ai)
#pragma unroll
            for (int m = 0; m < 4; ++m) {
                const int row = u.pm * 256 + ai * 128 + wr * 64 + m * 16 + fr;
                bf16_t* rowp = QK + (size_t)row * NQK;
#pragma unroll
                for (int bj = 0; bj < 2; ++bj) {
                    const int cbase = u.pn * 256 + bj * 128 + wc * 32;
                    if (cbase < 2048) {
#pragma unroll
                        for (int n = 0; n < 2; ++n) { const f32x4 v = acc[ai][bj][m][n]; u32x2 w; w.x = cvt_pk_bf16(v[0], v[1]); w.y = cvt_pk_bf16(v[2], v[3]); *(u32x2*)(rowp + cbase + 16 * n + 4 * fq) = w; }
                    } else {
                        const int blk64 = cbase >> 6, wcl = (cbase >> 5) & 1;
                        f32x4 x1 = acc[ai][bj][m][0], x2 = acc[ai][bj][m][1], o1 = x1, o2 = x2;
                        if (row >= 256) {
                            const int t = row - 256, pos = (blk64 & 1) ? (t & 63) : (t >> 6);
                            const f32x4* rp = (const f32x4*)(rope + pos * 32 + 16 * wcl + 4 * fq);
                            const f32x4 c01 = rp[0], c23 = rp[1];
                            const float cs_c[4] = {c01[0], c01[2], c23[0], c23[2]}, cs_s[4] = {c01[1], c01[3], c23[1], c23[3]};
#pragma unroll
                            for (int i = 0; i < 4; ++i) { o1[i] = x1[i] * cs_c[i] - x2[i] * cs_s[i]; o2[i] = x2[i] * cs_c[i] + x1[i] * cs_s[i]; }
                        }
                        bf16_t* dp = rowp + 64 * blk64 + 16 * wcl + 4 * fq;
                        u32x2 w; w.x = cvt_pk_bf16(o1[0], o1[1]); w.y = cvt_pk_bf16(o1[2], o1[3]); *(u32x2*)dp = w;
                        w.x = cvt_pk_bf16(o2[0], o2[1]); w.y = cvt_pk_bf16(o2[2], o2[3]); *(u32x2*)(dp + 32) = w;
                    }
                }
            }
    }
};
struct EpiBf16Plain {
    static constexpr bool AFTER_DRAIN = false;
    bf16_t* O; int ldc;
    __device__ __forceinline__ void operator()(AccRef acc, const pg8::Unit& u, int wr, int wc, int fr, int fq) const {
#pragma unroll
        for (int ai = 0; ai < 2; ++ai)
#pragma unroll
            for (int m = 0; m < 4; ++m) {
                const int row = u.pm * 256 + ai * 128 + wr * 64 + m * 16 + fr;
                bf16_t* rowp = O + (size_t)row * ldc + u.pn * 256 + wc * 32 + 4 * fq;
#pragma unroll
                for (int bj = 0; bj < 2; ++bj)
#pragma unroll
                    for (int n = 0; n < 2; ++n) { const f32x4 v = acc[ai][bj][m][n]; u32x2 w; w.x = cvt_pk_bf16(v[0], v[1]); w.y = cvt_pk_bf16(v[2], v[3]); *(u32x2*)(rowp + bj * 128 + 16 * n) = w; }
            }
    }
};
struct EpiRes {
    static constexpr bool AFTER_DRAIN = false;
    const float* base0; const float* base1; float* out; const float* gate0; const float* gate1; int rowoff; float* part;
    __device__ __forceinline__ void operator()(AccRef acc, const pg8::Unit& u, int wr, int wc, int fr, int fq) const {
        const int col0 = u.pn * 256 + wc * 32 + 4 * fq;
        const bool isctx = (u.pm * 256 + rowoff) < 256;
        const float* gate = isctx ? gate0 : gate1;
        f32x4 gv[2][2];
#pragma unroll
        for (int bj = 0; bj < 2; ++bj)
#pragma unroll
            for (int n = 0; n < 2; ++n) gv[bj][n] = *(const f32x4*)(gate + col0 + bj * 128 + n * 16);
        const int grow0 = u.pm * 256 + wr * 64 + fr + rowoff;
        if (u.split) {
            float* pbase = part + ((size_t)(u.kt0 >> 2) * 256 + wr * 64 + fr) * DM + col0;
#pragma unroll
            for (int ai = 0; ai < 2; ++ai)
#pragma unroll
                for (int m = 0; m < 4; ++m) {
                    float* op = pbase + (size_t)(ai * 128 + m * 16) * DM;
#pragma unroll
                    for (int bj = 0; bj < 2; ++bj)
#pragma unroll
                        for (int n = 0; n < 2; ++n) *(f32x4*)(op + bj * 128 + n * 16) = gv[bj][n] * acc[ai][bj][m][n];
                }
            return;
        }
#pragma unroll
        for (int ai = 0; ai < 2; ++ai)
#pragma unroll
            for (int m = 0; m < 4; ++m) {
                const int grow = grow0 + ai * 128 + m * 16;
                const float* bp = (isctx ? base0 + (size_t)grow * DM : base1 + (size_t)(grow - 256) * DM) + col0;
                float* op = out + (size_t)grow * DM + col0;
#pragma unroll
                for (int bj = 0; bj < 2; ++bj)
#pragma unroll
                    for (int n = 0; n < 2; ++n) { const f32x4 b = *(const f32x4*)(bp + bj * 128 + n * 16); *(f32x4*)(op + bj * 128 + n * 16) = b + gv[bj][n] * acc[ai][bj][m][n]; }
            }
    }
};
struct EpiResNormH {
    static constexpr bool AFTER_DRAIN = true;
    const float* base1; const float* gate0; const float* gate1; float* outf; float* part; float* ssp; const float* nw; const float* sc; const float* sh; bf16_t* H; const XcdBarrier* xbar;
    __device__ __forceinline__ void operator()(AccRef acc, const pg8::Unit& u, int wr, int wc, int fr, int fq) const {
        const int col0 = u.pn * 256 + wc * 32 + 4 * fq;
        float* pbase = part + ((size_t)(u.kt0 >> 2) * 256 + wr * 64 + fr) * DM + col0;
#pragma unroll
        for (int bj = 0; bj < 2; ++bj)
#pragma unroll
            for (int n = 0; n < 2; ++n) {
                const f32x4 gvv = *(const f32x4*)(gate0 + col0 + bj * 128 + n * 16);
#pragma unroll
                for (int ai = 0; ai < 2; ++ai)
#pragma unroll
                    for (int m = 0; m < 4; ++m) *(f32x4*)(pbase + (size_t)(ai * 128 + m * 16) * DM + bj * 128 + n * 16) = gvv * acc[ai][bj][m][n];
            }
    }
    __device__ __forceinline__ void fused(f32x4 (&acc)[2][2][4][2], const pg8::Unit& u, int wr, int wc, int fr, int fq, LAS unsigned char* ldsl) const {
        float* ssl = (float*)ldsl;
        float* rsl = ssl + 1024;
        const int col0 = u.pn * 256 + wc * 32 + 4 * fq, rl0 = wr * 64 + fr, pml = u.pm - 1;
        {
            f32x4 gv[2][2];
#pragma unroll
            for (int bj = 0; bj < 2; ++bj)
#pragma unroll
                for (int n = 0; n < 2; ++n) gv[bj][n] = *(const f32x4*)(gate1 + col0 + bj * 128 + n * 16);
#pragma unroll
            for (int ai = 0; ai < 2; ++ai)
#pragma unroll
                for (int m = 0; m < 4; ++m) {
                    const int rl = rl0 + ai * 128 + m * 16;
                    const float* bp = base1 + (size_t)(pml * 256 + rl) * DM + col0;
                    float* op = outf + (size_t)(u.pm * 256 + rl) * DM + col0;
                    float ss = 0.f;
#pragma unroll
                    for (int bj = 0; bj < 2; ++bj)
#pragma unroll
                        for (int n = 0; n < 2; ++n) {
                            const f32x4 v = *(const f32x4*)(bp + bj * 128 + n * 16) + gv[bj][n] * acc[ai][bj][m][n];
                            acc[ai][bj][m][n] = v;
                            *(f32x4*)(op + bj * 128 + n * 16) = v;
                            ss += v[0] * v[0] + v[1] * v[1] + v[2] * v[2] + v[3] * v[3];
                        }
                    ss += __shfl_xor(ss, 16); ss += __shfl_xor(ss, 32);
                    if (fq == 0) ssl[rl * 4 + wc] = ss;
                }
        }
        __syncthreads();
        if (threadIdx.x < 256) { const int r = threadIdx.x; ssp[((size_t)pml * 8 + u.pn) * 256 + r] = ssl[r * 4] + ssl[r * 4 + 1] + ssl[r * 4 + 2] + ssl[r * 4 + 3]; }
        xcd_barrier(*xbar);
        if (threadIdx.x < 256) {
            const int r = threadIdx.x; float tot = 0.f;
#pragma unroll
            for (int pn = 0; pn < 8; ++pn) tot += ssp[((size_t)pml * 8 + pn) * 256 + r];
            rsl[r] = rsqrtf(tot * (1.f / DM) + 1e-6f);
        }
        __syncthreads();
#pragma unroll
        for (int bj = 0; bj < 2; ++bj)
#pragma unroll
            for (int n = 0; n < 2; ++n) {
                const int col = col0 + bj * 128 + n * 16;
                const f32x4 w4 = *(const f32x4*)(nw + col), sc4 = *(const f32x4*)(sc + col), sh4 = *(const f32x4*)(sh + col);
                const f32x4 ws4 = w4 * (sc4 + 1.f);
#pragma unroll
                for (int ai = 0; ai < 2; ++ai)
#pragma unroll
                    for (int m = 0; m < 4; ++m) {
                        const int rl = rl0 + ai * 128 + m * 16;
                        const f32x4 o = acc[ai][bj][m][n] * rsl[rl] * ws4 + sh4;
                        u32x2 pk; pk.x = cvt_pk_bf16(o[0], o[1]); pk.y = cvt_pk_bf16(o[2], o[3]);
                        *(u32x2*)(H + (size_t)(u.pm * 256 + rl) * DM + col) = pk;
                    }
            }
    }
};
struct EpiResNorm {
    static constexpr bool AFTER_DRAIN = true;
    const float* base1; const float* gate1; const float* nw; float* out; float* ssp; const XcdBarrier* xbar;
    __device__ __forceinline__ void operator()(AccRef, const pg8::Unit&, int, int, int, int) const {}
    __device__ __forceinline__ void fused(f32x4 (&acc)[2][2][4][2], const pg8::Unit& u, int wr, int wc, int fr, int fq, LAS unsigned char* ldsl) const {
        float* ssl = (float*)ldsl;
        float* rsl = ssl + 1024;
        const int col0 = u.pn * 256 + wc * 32 + 4 * fq, rl0 = wr * 64 + fr;
        f32x4 gv[2][2];
#pragma unroll
        for (int bj = 0; bj < 2; ++bj)
#pragma unroll
            for (int n = 0; n < 2; ++n) gv[bj][n] = *(const f32x4*)(gate1 + col0 + bj * 128 + n * 16);
#pragma unroll
        for (int ai = 0; ai < 2; ++ai)
#pragma unroll
            for (int m = 0; m < 4; ++m) {
                const int rl = rl0 + ai * 128 + m * 16;
                const float* bp = base1 + (size_t)(u.pm * 256 + rl) * DM + col0;
                float ss = 0.f;
#pragma unroll
                for (int bj = 0; bj < 2; ++bj)
#pragma unroll
                    for (int n = 0; n < 2; ++n) {
                        const f32x4 v = *(const f32x4*)(bp + bj * 128 + n * 16) + gv[bj][n] * acc[ai][bj][m][n];
                        acc[ai][bj][m][n] = v;
                        ss += v[0] * v[0] + v[1] * v[1] + v[2] * v[2] + v[3] * v[3];
                    }
                ss += __shfl_xor(ss, 16); ss += __shfl_xor(ss, 32);
                if (fq == 0) ssl[rl * 4 + wc] = ss;
            }
        __syncthreads();
        if (threadIdx.x < 256) { const int r = threadIdx.x; ssp[((size_t)u.pm * 8 + u.pn) * 256 + r] = ssl[r * 4] + ssl[r * 4 + 1] + ssl[r * 4 + 2] + ssl[r * 4 + 3]; }
        xcd_barrier(*xbar);
        if (threadIdx.x < 256) {
            const int r = threadIdx.x; float tot = 0.f;
#pragma unroll
            for (int pn = 0; pn < 8; ++pn) tot += ssp[((size_t)u.pm * 8 + pn) * 256 + r];
            rsl[r] = rsqrtf(tot * (1.f / DM) + 1e-6f);
        }
        __syncthreads();
        f32x4 wv[2][2];
#pragma unroll
        for (int bj = 0; bj < 2; ++bj)
#pragma unroll
            for (int n = 0; n < 2; ++n) wv[bj][n] = *(const f32x4*)(nw + col0 + bj * 128 + n * 16);
#pragma unroll
        for (int ai = 0; ai < 2; ++ai)
#pragma unroll
            for (int m = 0; m < 4; ++m) {
                const int rl = rl0 + ai * 128 + m * 16;
                const float r = rsl[rl];
                float* op = out + (size_t)(u.pm * 256 + rl) * DM + col0;
#pragma unroll
                for (int bj = 0; bj < 2; ++bj)
#pragma unroll
                    for (int n = 0; n < 2; ++n) *(f32x4*)(op + bj * 128 + n * 16) = acc[ai][bj][m][n] * r * wv[bj][n];
            }
    }
};
struct EpiSwiGLU {
    static constexpr bool AFTER_DRAIN = false;
    bf16_t* U;
    __device__ __forceinline__ void operator()(AccRef acc, const pg8::Unit& u, int wr, int wc, int fr, int fq) const {
#pragma unroll
        for (int ai = 0; ai < 2; ++ai) {
            if (u.half != 0 && u.half != ai + 1) continue;
#pragma unroll
            for (int m = 0; m < 4; ++m) {
                const int row = u.pm * 256 + ai * 128 + wr * 64 + m * 16 + fr;
                bf16_t* rowp = U + (size_t)row * DFF;
#pragma unroll
                for (int bj = 0; bj < 2; ++bj) {
                    const int G = (u.pn * 256 + bj * 128 + wc * 32) >> 5;
                    const f32x4 a = acc[ai][bj][m][0], b = acc[ai][bj][m][1]; float o[4];
#pragma unroll
                    for (int i = 0; i < 4; ++i) o[i] = a[i] * __builtin_amdgcn_rcpf(1.f + __expf(-a[i])) * b[i];
                    u32x2 w; w.x = cvt_pk_bf16(o[0], o[1]); w.y = cvt_pk_bf16(o[2], o[3]); *(u32x2*)(rowp + 16 * G + 4 * fq) = w;
                }
            }
        }
    }
};
struct EpiGLU {
    static constexpr bool AFTER_DRAIN = false;
    const float* base; float* out; const float* gate; const float* bglu;
    __device__ __forceinline__ void operator()(AccRef acc, const pg8::Unit& u, int wr, int wc, int fr, int fq) const {
#pragma unroll
        for (int bj = 0; bj < 2; ++bj) {
            const int G = (u.pn * 256 + bj * 128 + wc * 32) >> 5, col = 16 * G + 4 * fq;
            const f32x4 gv = *(const f32x4*)(gate + col), bv = *(const f32x4*)(bglu + col), bg = *(const f32x4*)(bglu + 2048 + col);
#pragma unroll
            for (int ai = 0; ai < 2; ++ai)
#pragma unroll
                for (int m = 0; m < 4; ++m) {
                    const int row = u.pm * 256 + ai * 128 + wr * 64 + m * 16 + fr;
                    const f32x4 b = *(const f32x4*)(base + (size_t)row * DM + col);
                    const f32x4 v = acc[ai][bj][m][0] + bv, gt = acc[ai][bj][m][1] + bg; f32x4 o;
#pragma unroll
                    for (int i = 0; i < 4; ++i) o[i] = b[i] + gv[i] * (v[i] * __builtin_amdgcn_rcpf(1.f + __expf(-gt[i])));
                    *(f32x4*)(out + (size_t)row * DM + col) = o;
                }
        }
    }
};

__device__ __forceinline__ void dsincos(double x, double& s, double& c) {
    const double kd = rint(x * 0.63661977236758134308);
    double r = fma(-kd, 1.57079632679489655800e+00, x);
    r = fma(-kd, 6.12323399573676603587e-17, r);
    const long long k = (long long)kd;
    const double r2 = r * r;
    const double sp = r * (1.0 + r2 * (-1.0 / 6.0 + r2 * (1.0 / 120.0 + r2 * (-1.0 / 5040.0 + r2 * (1.0 / 362880.0 + r2 * (-1.0 / 39916800.0 + r2 * (1.0 / 6227020800.0 + r2 * (-1.0 / 1307674368000.0))))))));
    const double cp = 1.0 + r2 * (-0.5 + r2 * (1.0 / 24.0 + r2 * (-1.0 / 720.0 + r2 * (1.0 / 40320.0 + r2 * (-1.0 / 3628800.0 + r2 * (1.0 / 479001600.0 + r2 * (-1.0 / 87178291200.0 + r2 * (1.0 / 20922789888000.0))))))));
    const int q = (int)(k & 3);
    s = (q == 0) ? sp : (q == 1) ? cp : (q == 2) ? -sp : -cp;
    c = (q == 0) ? cp : (q == 1) ? -sp : (q == 2) ? -cp : sp;
}
__device__ __forceinline__ int ropeperm(int p) { const int q = p & 63; return (p & ~63) + 32 * ((q & 31) >> 4) + 16 * (q >> 5) + (q & 15); }

constexpr int CONV_L0_TILES = 2944, CONV_ALL_TILES = 5568;
__device__ void conv_tiles(const Params& p, int t_begin, int t_end, int rank, int nranks) {
    unsigned char* ws = p.ws;
    int tid = threadIdx.x; asm volatile("" : "+v"(tid));
    const int wv = tid >> 6, ln = tid & 63;
    auto decode = [&](int tix, const float*& src, int& ld, bf16_t*& dst, int& K) {
        int local, Nd, kind; const float* s0; const float* s1; bf16_t* d0;
        if (tix < 416)        { local = tix;         Nd = NQK;  K = DM;  ld = 4608; kind = 0; s0 = p.w_in; s1 = s0; d0 = (bf16_t*)(ws + OFF_WQK); }
        else if (tix < 576)   { local = tix - 416;   Nd = NV;   K = DM;  ld = 4608; kind = 1; s0 = p.w_in; s1 = s0; d0 = (bf16_t*)(ws + OFF_WV); }
        else if (tix < 832)   { local = tix - 576;   Nd = DM;   K = DM;  ld = DM;   kind = 2; s0 = p.w_out; s1 = s0; d0 = (bf16_t*)(ws + OFF_WO); }
        else if (tix < 2240)  { local = tix - 832;   Nd = 2 * DFF; K = DM; ld = DFF; kind = 3; s0 = p.w1; s1 = p.w3; d0 = (bf16_t*)(ws + OFF_W13); }
        else if (tix < 2944)  { local = tix - 2240;  Nd = DM;   K = DFF; ld = DM;   kind = 2; s0 = p.w2; s1 = s0; d0 = (bf16_t*)(ws + OFF_W2); }
        else if (tix < 4352)  { local = tix - 2944;  Nd = 2 * DFF; K = DM; ld = DFF; kind = 3; s0 = p.w1 + (size_t)DM * DFF; s1 = p.w3 + (size_t)DM * DFF; d0 = (bf16_t*)(ws + OFF_W13) + (size_t)2 * DFF * DM; }
        else if (tix < 5056)  { local = tix - 4352;  Nd = DM;   K = DFF; ld = DM;   kind = 2; s0 = p.w2 + (size_t)DFF * DM; s1 = s0; d0 = (bf16_t*)(ws + OFF_W2) + (size_t)DM * DFF; }
        else                  { local = tix - 5056;  Nd = 4096; K = DM;  ld = 4096; kind = 4; s0 = p.w_glu; s1 = s0; d0 = (bf16_t*)(ws + OFF_WGLU); }
        const int nbn = Nd >> 8, kblk = local / nbn, nblk = local % nbn, k0 = kblk * 64 + 8 * (ln & 7), np = nblk * 256 + 32 * wv + 4 * (ln >> 3);
        const float* sp = s0; int col = np;
        if (kind == 0) { col = (np < 2048) ? np : (np < 3072) ? 3072 + ropeperm(np - 2048) : 4096 + ropeperm(np - 3072); }
        else if (kind == 1) { col = (np < 1024) ? 2048 + np : 4352 + (np - 1024); }
        else if (kind == 3) { const int G = np >> 5, r = np & 31; sp = (r < 16) ? s0 : s1; col = 16 * G + (r & 15); }
        else if (kind == 4) { const int G = np >> 5, r = np & 31; col = ((r < 16) ? 0 : 2048) + 16 * G + (r & 15); }
        src = sp + (size_t)k0 * ld + col;
        dst = d0 + (size_t)np * K + k0;
    };
    int tix = t_begin + rank;
    const float* src = nullptr; int ld = 0, K = 0; bf16_t* dst = nullptr;
    f32x4 cur[8];
    if (tix < t_end) {
        decode(tix, src, ld, dst, K);
#pragma unroll
        for (int j = 0; j < 8; ++j) cur[j] = *(const f32x4*)(src + (size_t)j * ld);
    }
    for (; tix < t_end; tix += nranks) {
        const int ntix = tix + nranks;
        const float* nsrc = src; int nld = ld, nK = K; bf16_t* ndst = dst;
        f32x4 nxt[8];
#pragma unroll
        for (int j = 0; j < 8; ++j) nxt[j] = (f32x4){0.f, 0.f, 0.f, 0.f};
        if (ntix < t_end) {
            decode(ntix, nsrc, nld, ndst, nK);
#pragma unroll
            for (int j = 0; j < 8; ++j) nxt[j] = *(const f32x4*)(nsrc + (size_t)j * nld);
        }
#pragma unroll
        for (int c = 0; c < 4; ++c) {
            u32x4 w; w.x = cvt_pk_bf16(cur[0][c], cur[1][c]); w.y = cvt_pk_bf16(cur[2][c], cur[3][c]); w.z = cvt_pk_bf16(cur[4][c], cur[5][c]); w.w = cvt_pk_bf16(cur[6][c], cur[7][c]);
            *(u32x4*)(dst + (size_t)c * K) = w;
        }
        src = nsrc; ld = nld; K = nK; dst = ndst;
#pragma unroll
        for (int j = 0; j < 8; ++j) cur[j] = nxt[j];
    }
}

__device__ void ada_gemv(const Params& p, unsigned char* lds, int cb_begin, int cb_end, int rank, int nranks) {
    int tid = threadIdx.x; asm volatile("" : "+v"(tid));
    float* lf = (float*)lds;
    for (int i = tid; i < DM; i += 512) { const float a = p.c[i], b = p.c_ctx[i]; lf[i] = a / (1.f + __expf(-a)); lf[DM + i] = b / (1.f + __expf(-b)); }
    __syncthreads();
    float* part = lf + 2 * DM;
    float* MOD = (float*)(p.ws + OFF_MOD);
    for (int cb = cb_begin + rank; cb < cb_end; cb += nranks) {
        const int layer = cb >> 8, col0 = (cb & 255) * 48;
        if (tid < 384) {
            const int cgp = tid % 12, ks = tid / 12;
            const float* w = p.ada_w + (size_t)layer * DM * 12288 + (size_t)(ks * 64) * 12288 + col0 + 4 * cgp;
            f32x4 a0 = {0.f, 0.f, 0.f, 0.f}, a1 = {0.f, 0.f, 0.f, 0.f};
#pragma unroll 16
            for (int k = 0; k < 64; ++k) { const f32x4 wv = *(const f32x4*)(w + (size_t)k * 12288); const float s0 = lf[ks * 64 + k], s1 = lf[DM + ks * 64 + k]; a0 += s0 * wv; a1 += s1 * wv; }
            float* pp = part + (ks * 12 + cgp) * 8;
            *(f32x4*)pp = a0; *(f32x4*)(pp + 4) = a1;
        }
        __syncthreads();
        if (tid < 96) {
            const int cgp = tid >> 3, j = tid & 7, v = j >> 2, e = j & 3;
            float sacc = 0.f;
#pragma unroll
            for (int ks = 0; ks < 32; ++ks) sacc += part[(ks * 12 + cgp) * 8 + j];
            const int col = col0 + 4 * cgp + e;
            MOD[(layer * 2 + v) * 12288 + col] = sacc + p.ada_b[layer * 12288 + col];
        }
        __syncthreads();
    }
}

__device__ void p0_prologue(const Params& p, unsigned char* lds) {
    const int tid = threadIdx.x;
    float* lf = (float*)lds;
    unsigned char* ws = p.ws;
    ada_gemv(p, lds, 0, 256, blockIdx.x, gridDim.x);
    conv_tiles(p, 0, CONV_L0_TILES, blockIdx.x, gridDim.x);
    {
        const int gtid = blockIdx.x * 512 + tid, gstride = gridDim.x * 512;
        float2* rope = (float2*)(ws + OFF_ROPE);
        for (int idx = gtid; idx < 4096; idx += gstride) {
            const int pos = idx >> 5, j = idx & 31;
            const float inv = (float)exp(-(double)j / 32.0 * 9.210340371976184);
            const float ang = (float)pos * inv;
            double s, c; dsincos((double)ang, s, c);
            rope[idx] = make_float2((float)c, (float)s);
        }
        float2* LAM = (float2*)(ws + OFF_LAM); float2* LAML = (float2*)(ws + OFF_LAML);
        bf16_t* BBT = (bf16_t*)(ws + OFF_BBT); bf16_t* CCM = (bf16_t*)(ws + OFF_CCM);
        for (int idx = blockIdx.x * 64 + tid; tid < 64 && idx < 16384; idx += gridDim.x * 64) {
            const int pr = idx >> 6, pp = idx & 63;
            const double dt = exp((double)p.log_dt[pr]);
            const double ar = (double)p.a_re[idx], ai = (double)p.a_im[idx];
            const double mag = exp(ar * dt);
            double sn, cs; dsincos(ai * dt, sn, cs);
            const double lr = mag * cs, li = mag * sn;
            LAM[idx] = make_float2((float)lr, (float)li);
            const double magL = exp(ar * dt * (double)SEG_STEPS);
            double snL, csL; dsincos(ai * dt * (double)SEG_STEPS, snL, csL);
            LAML[idx] = make_float2((float)(magL * csL), (float)(magL * snL));
            const double den = ar * ar + ai * ai, nr = lr - 1.0;
            const double cr = (nr * ar + li * ai) / den, ci = (li * ar - nr * ai) / den;
            const float* br = p.b_re + (size_t)idx * 16; const float* bi = p.b_im + (size_t)idx * 16;
            bf16_t* d0 = BBT + ((size_t)pr * 128 + pp) * 16;
#pragma unroll
            for (int h = 0; h < 16; h += 2) {
                const double br0 = br[h], bi0 = bi[h], br1 = br[h + 1], bi1 = bi[h + 1];
                *(unsigned*)(d0 + h) = cvt_pk_bf16((float)(cr * br0 - ci * bi0), (float)(cr * br1 - ci * bi1));
                *(unsigned*)(d0 + 64 * 16 + h) = cvt_pk_bf16((float)(cr * bi0 + ci * br0), (float)(cr * bi1 + ci * br1));
            }
#pragma unroll
            for (int h = 0; h < 16; ++h) {
                const float cre = p.c_re[((size_t)pr * 16 + h) * 64 + pp], cim = p.c_im[((size_t)pr * 16 + h) * 64 + pp];
                *(unsigned*)(CCM + ((size_t)pr * 16 + h) * 128 + 2 * pp) = cvt_pk_bf16(cre, -cim);
            }
            {
                const double m32 = exp(ar * dt * 32.0); double s32, c32; dsincos(ai * dt * 32.0, s32, c32);
                ((float2*)(ws + OFF_LAM32))[idx] = make_float2((float)(m32 * c32), (float)(m32 * s32));
            }
        }
        for (int u = gtid; u < 16384 * 32; u += gstride) {
            const int idx = u >> 5, k = u & 31, pr = idx >> 6;
            const double dt = exp((double)p.log_dt[pr]), kd = (double)k;
            const double mg = exp((double)p.a_re[idx] * dt * kd);
            double sn, cs; dsincos((double)p.a_im[idx] * dt * kd, sn, cs);
            ((float2*)(ws + OFF_LAMPOW))[u] = make_float2((float)(mg * cs), (float)(mg * sn));
        }
    }
}

__device__ void norm_phase(const float* src0, const float* src1, int row_begin, int row_end, const float* nw, const float* modl, int sc_chunk, int sh_chunk, bf16_t* H,
                           const float* part, int npart, float* ctx_copy) {
    const int lane = threadIdx.x & 63, wave = threadIdx.x >> 6, gw = blockIdx.x * 8 + wave, nwv = gridDim.x * 8;
    const int n_ctx = (row_begin < 256) ? (256 - blockIdx.x + (int)gridDim.x - 1) / (int)gridDim.x : 0;
    const int lat0 = (row_begin < 256) ? 256 : row_begin;
    const int n_lat = (row_end - lat0 - gw + nwv - 1) / nwv;
    const int n_mine = ((wave == 0) ? n_ctx : 0) + (n_lat > 0 ? n_lat : 0);
    for (int it = 0; it < n_mine; ++it) {
        const bool isctx = (wave == 0) && (it < n_ctx);
        const int row = isctx ? (blockIdx.x + it * gridDim.x) : (lat0 + gw + (it - ((wave == 0) ? n_ctx : 0)) * nwv);
        const float* xr = isctx ? src0 + (size_t)row * DM : src1 + (size_t)(row - 256) * DM;
        const float* mv = modl + (isctx ? 12288 : 0);
        f32x4 xv[8];
#pragma unroll
        for (int i = 0; i < 8; ++i) xv[i] = *(const f32x4*)(xr + (i * 64 + lane) * 4);
        if (isctx) {
            for (int k = 0; k < npart; ++k) {
                const float* pr = part + ((size_t)k * 256 + row) * DM;
#pragma unroll
                for (int i = 0; i < 8; ++i) xv[i] += *(const f32x4*)(pr + (i * 64 + lane) * 4);
            }
            if (ctx_copy != nullptr) {
#pragma unroll
                for (int i = 0; i < 8; ++i) *(f32x4*)(ctx_copy + (size_t)row * DM + (i * 64 + lane) * 4) = xv[i];
            }
        }
        float ss = 0.f;
#pragma unroll
        for (int i = 0; i < 8; ++i) ss += xv[i][0] * xv[i][0] + xv[i][1] * xv[i][1] + xv[i][2] * xv[i][2] + xv[i][3] * xv[i][3];
        ss = wave_sum(ss);
        const float r = rsqrtf(ss * (1.f / DM) + 1e-6f);
#pragma unroll
        for (int i = 0; i < 8; ++i) {
            const int col = (i * 64 + lane) * 4;
            const f32x4 w = *(const f32x4*)(nw + col), sc = *(const f32x4*)(mv + sc_chunk * DM + col), sh = *(const f32x4*)(mv + sh_chunk * DM + col);
            float o[4];
#pragma unroll
            for (int j = 0; j < 4; ++j) o[j] = xv[i][j] * r * w[j] * (1.f + sc[j]) + sh[j];
            u32x2 pk; pk.x = cvt_pk_bf16(o[0], o[1]); pk.y = cvt_pk_bf16(o[2], o[3]);
            *(u32x2*)(H + (size_t)row * DM + col) = pk;
        }
    }
}
__device__ void final_norm_phase(const float* src, const float* nw, float* out) {
    const int lane = threadIdx.x & 63, gw = blockIdx.x * 8 + (threadIdx.x >> 6), nwv = gridDim.x * 8;
    for (int row = gw; row < SEQ; row += nwv) {
        const float* xr = src + (size_t)row * DM;
        f32x4 xv[8]; float ss = 0.f;
#pragma unroll
        for (int i = 0; i < 8; ++i) { xv[i] = *(const f32x4*)(xr + (i * 64 + lane) * 4); ss += xv[i][0] * xv[i][0] + xv[i][1] * xv[i][1] + xv[i][2] * xv[i][2] + xv[i][3] * xv[i][3]; }
        ss = wave_sum(ss);
        const float r = rsqrtf(ss * (1.f / DM) + 1e-6f);
#pragma unroll
        for (int i = 0; i < 8; ++i) { const int col = (i * 64 + lane) * 4; const f32x4 w = *(const f32x4*)(nw + col); *(f32x4*)(out + (size_t)row * DM + col) = xv[i] * r * w; }
    }
}

constexpr int AT_KBYTES = 64 * 256, AT_VPITCH = 144, AT_VBYTES = 128 * AT_VPITCH, AT_STAGE = AT_KBYTES + AT_VBYTES, AT_TBL_OFF = 2 * AT_STAGE;
static_assert(AT_TBL_OFF + 8 * 2048 <= 8 * 18432, "attention LDS");
__device__ void attn_phase(const Params& p, unsigned char* lds) {
    const int tid = threadIdx.x, lane = tid & 63, wave = tid >> 6;
    const int r16 = lane & 15, g4 = lane >> 4;
    const bf16_t* QK = (const bf16_t*)(p.ws + OFF_QK); const bf16_t* VT = (const bf16_t*)(p.ws + OFF_VT); bf16_t* O = (bf16_t*)(p.ws + OFF_O);
    constexpr float LOG2E = 1.4426950408889634f, SC2 = 0.08838834764831845f * 1.4426950408889634f, NEG = -1e30f;
    float* tbl = (float*)(lds + AT_TBL_OFF + wave * 2048);
    int tbl_head = -1;
    const int xcd = blockIdx.x & 7, bl = blockIdx.x >> 3, nbl = gridDim.x >> 3;
    int kkey[2], kdc[2], klds[2], vd[2], vj[2], vlds[2];
#pragma unroll
    for (int i = 0; i < 2; ++i) {
        const int u = tid + 512 * i;
        kkey[i] = u >> 4; kdc[i] = u & 15;
        const int swz = (kkey[i] & 3) | (((kkey[i] >> 3) & 3) << 2);
        klds[i] = kkey[i] * 256 + 16 * (kdc[i] ^ swz);
        vd[i] = u >> 3; vj[i] = u & 7; vlds[i] = AT_KBYTES + vd[i] * AT_VPITCH + 16 * vj[i];
    }
    for (int q = bl; q < 132; q += nbl) {
        int type, kcol, vrow0, nloc_rounds, loc_row0, loc_stride;
        int qrow0, qcol, ocol, hq = 0; bool has_sink = false;
        int na_h = 0, na_r = 0, na_kr0 = 0, na_kc0 = 0, na_qc = 0, na_krlo = 0, sw_q0 = 0, sw_base = 0;
        if (q < 64) {
            type = 0; na_h = xcd; const int r_lo = 2 * q; na_r = r_lo + (wave >> 2); const int n = wave & 3;
            kcol = 1024 + na_h * 128; vrow0 = na_h * 128;
            na_krlo = min(max(r_lo - 4, 0), 120); const int kr_hi = min(max(r_lo + 1 - 4, 0), 120) + 7;
            nloc_rounds = kr_hi - na_krlo + 1; loc_row0 = 256 + na_krlo * 64; loc_stride = 64;
            qrow0 = 256 + na_r * 64 + 16 * n; qcol = na_h * 128; ocol = na_h * 128;
            na_kr0 = min(max(na_r - 4, 0), 120); na_kc0 = min(max(16 * n - 8, 0), 32); na_qc = 16 * n + r16;
            if (tbl_head != na_h) {
                for (int i = lane; i < 465; i += 64) tbl[i] = p.rpb[na_h * 465 + i] * LOG2E;
                tbl_head = na_h;
            }
        } else if (q < 128) {
            type = 1; const int kvh = xcd >> 2, span = (xcd & 3) * 64 + (q - 64); hq = kvh * 4 + (wave & 3);
            kcol = 3072 + kvh * 128; vrow0 = 1024 + kvh * 128;
            sw_base = span * 32 - 128; nloc_rounds = 5; loc_row0 = 256 + sw_base; loc_stride = 64;
            sw_q0 = span * 32 + 16 * (wave >> 2); qrow0 = 256 + sw_q0; qcol = 2048 + hq * 128; ocol = 1024 + hq * 128; has_sink = true;
        } else {
            type = 2; const int id = xcd * 4 + (q - 128), hh = id >> 1, half = id & 1;
            nloc_rounds = 0; loc_row0 = 0; loc_stride = 0;
            qrow0 = 16 * (half * 8 + wave);
            if (hh < 8) { qcol = hh * 128; kcol = 1024 + hh * 128; vrow0 = hh * 128; ocol = hh * 128; }
            else { hq = hh - 8; qcol = 2048 + hq * 128; kcol = 3072 + (hq >> 2) * 128; vrow0 = 1024 + (hq >> 2) * 128; ocol = 1024 + hq * 128; has_sink = true; }
        }
        const int nrounds = 4 + nloc_rounds;
        bf16x8 qf[4];
        { const bf16_t* qp = QK + (size_t)(qrow0 + r16) * NQK + qcol + 8 * g4;
#pragma unroll
          for (int ks = 0; ks < 4; ++ks) qf[ks] = *(const bf16x8*)(qp + 32 * ks); }
        float m_run = has_sink ? p.sink[hq] * LOG2E : NEG;
        float l_run = (has_sink && g4 == 0) ? 1.f : 0.f;
        f32x4 oacc[8];
#pragma unroll
        for (int db = 0; db < 8; ++db) oacc[db] = (f32x4){0.f, 0.f, 0.f, 0.f};

        u32x4 stg[4];
        auto stage_load = [&](int rd) {
            const int row0 = (rd < 4) ? 64 * rd : loc_row0 + (rd - 4) * loc_stride;
#pragma unroll
            for (int i = 0; i < 2; ++i) {
                const int kr = min(row0 + kkey[i], MROWS - 1);
                stg[i] = *(const u32x4*)(QK + (size_t)kr * NQK + kcol + 8 * kdc[i]);
                const int vc = min(row0 + 8 * vj[i], MROWS - 8);
                stg[2 + i] = *(const u32x4*)(VT + (size_t)(vrow0 + vd[i]) * MROWS + vc);
            }
        };
        auto stage_store = [&](int buf) {
            unsigned char* sb = lds + buf * AT_STAGE;
#pragma unroll
            for (int i = 0; i < 2; ++i) { *(u32x4*)(sb + klds[i]) = stg[i]; *(u32x4*)(sb + vlds[i]) = stg[2 + i]; }
        };
        auto chunk = [&](const unsigned char* sb, int koff, int mode, int brow, int kpos0) {
            f32x4 sacc[2];
#pragma unroll
            for (int jb = 0; jb < 2; ++jb) {
                const int kap = koff + 8 * (r16 >> 2) + 4 * jb + (r16 & 3);
                const int swz = (kap & 3) | (((kap >> 3) & 3) << 2);
                const unsigned char* kb = sb + kap * 256;
                sacc[jb] = (f32x4){0.f, 0.f, 0.f, 0.f};
#pragma unroll
                for (int ks = 0; ks < 4; ++ks) {
                    const bf16x8 kf = *(const bf16x8*)(kb + 16 * ((4 * ks + g4) ^ swz));
                    sacc[jb] = __builtin_amdgcn_mfma_f32_16x16x32_bf16(kf, qf[ks], sacc[jb], 0, 0, 0);
                }
            }
            float s[8];
#pragma unroll
            for (int jb = 0; jb < 2; ++jb)
#pragma unroll
                for (int i = 0; i < 4; ++i) s[4 * jb + i] = sacc[jb][i] * SC2;
            if (mode == 1) {
                const int ws0 = min(max(na_qc - 8, 0), 48);
                const float* rp = tbl + brow * 31;
                float bias[8];
#pragma unroll
                for (int e = 0; e < 8; ++e) bias[e] = rp[min(max(na_kc0 + 8 * g4 + e - na_qc + 15, 0), 30)];
#pragma unroll
                for (int e = 0; e < 8; ++e) {
                    const int kc = na_kc0 + 8 * g4 + e;
                    const bool valid = (kc >= ws0) && (kc < ws0 + 16);
                    s[e] = valid ? s[e] + bias[e] : NEG;
                }
            } else if (mode == 2) {
                const int qpos = sw_q0 + r16;
#pragma unroll
                for (int e = 0; e < 8; ++e) {
                    const int kpos = kpos0 + 8 * g4 + e, d = kpos - qpos;
                    const bool valid = (kpos >= 0) && (kpos < SEQ) && (d <= 128) && (d >= -128);
                    s[e] = valid ? s[e] : NEG;
                }
            }
            float cm = fmaxf(fmaxf(fmaxf(s[0], s[1]), fmaxf(s[2], s[3])), fmaxf(fmaxf(s[4], s[5]), fmaxf(s[6], s[7])));
            cm = fmaxf(cm, __shfl_xor(cm, 16)); cm = fmaxf(cm, __shfl_xor(cm, 32));
            const float m_new = fmaxf(m_run, cm);
            const float alpha = __builtin_amdgcn_exp2f(m_run - m_new);
            float pv[8], ps = 0.f;
#pragma unroll
            for (int e = 0; e < 8; ++e) { pv[e] = __builtin_amdgcn_exp2f(s[e] - m_new); ps += pv[e]; }
            l_run = l_run * alpha + ps; m_run = m_new;
            u32x4 pw; pw.x = cvt_pk_bf16(pv[0], pv[1]); pw.y = cvt_pk_bf16(pv[2], pv[3]); pw.z = cvt_pk_bf16(pv[4], pv[5]); pw.w = cvt_pk_bf16(pv[6], pv[7]);
            const bf16x8 pf = __builtin_bit_cast(bf16x8, pw);
            const unsigned char* vb = sb + AT_KBYTES + r16 * AT_VPITCH + 2 * (koff + 8 * g4);
            if (__builtin_amdgcn_ballot_w64(alpha != 1.f) != 0ull) {
#pragma unroll
                for (int db = 0; db < 8; ++db) oacc[db] *= alpha;
            }
#pragma unroll
            for (int db = 0; db < 8; ++db) {
                const bf16x8 vf = *(const bf16x8*)(vb + 16 * db * AT_VPITCH);
                oacc[db] = __builtin_amdgcn_mfma_f32_16x16x32_bf16(vf, pf, oacc[db], 0, 0, 0);
            }
        };

        auto chunk2 = [&](const unsigned char* sb, int mode, int kpos0) {
            f32x4 sacc[2][2];
#pragma unroll
            for (int hf = 0; hf < 2; ++hf)
#pragma unroll
                for (int jb = 0; jb < 2; ++jb) {
                    const int kap = 32 * hf + 8 * (r16 >> 2) + 4 * jb + (r16 & 3);
                    const int swz = (kap & 3) | (((kap >> 3) & 3) << 2);
                    const unsigned char* kb = sb + kap * 256;
                    sacc[hf][jb] = (f32x4){0.f, 0.f, 0.f, 0.f};
#pragma unroll
                    for (int ks = 0; ks < 4; ++ks) {
                        const bf16x8 kf = *(const bf16x8*)(kb + 16 * ((4 * ks + g4) ^ swz));
                        sacc[hf][jb] = __builtin_amdgcn_mfma_f32_16x16x32_bf16(kf, qf[ks], sacc[hf][jb], 0, 0, 0);
                    }
                }
            float s[16];
#pragma unroll
            for (int hf = 0; hf < 2; ++hf)
#pragma unroll
                for (int jb = 0; jb < 2; ++jb)
#pragma unroll
                    for (int i = 0; i < 4; ++i) s[8 * hf + 4 * jb + i] = sacc[hf][jb][i] * SC2;
            if (mode == 2) {
                const int qpos = sw_q0 + r16;
#pragma unroll
                for (int hf = 0; hf < 2; ++hf)
#pragma unroll
                    for (int e = 0; e < 8; ++e) {
                        const int kpos = kpos0 + 32 * hf + 8 * g4 + e, d = kpos - qpos;
                        const bool valid = (kpos >= 0) && (kpos < SEQ) && (d <= 128) && (d >= -128);
                        s[8 * hf + e] = valid ? s[8 * hf + e] : NEG;
                    }
            }
            float cm = s[0];
#pragma unroll
            for (int e = 1; e < 16; ++e) cm = fmaxf(cm, s[e]);
            cm = fmaxf(cm, __shfl_xor(cm, 16)); cm = fmaxf(cm, __shfl_xor(cm, 32));
            const float m_new = fmaxf(m_run, cm);
            const float alpha = __builtin_amdgcn_exp2f(m_run - m_new);
            float pv[16], ps = 0.f;
#pragma unroll
            for (int e = 0; e < 16; ++e) { pv[e] = __builtin_amdgcn_exp2f(s[e] - m_new); ps += pv[e]; }
            l_run = l_run * alpha + ps; m_run = m_new;
            if (__builtin_amdgcn_ballot_w64(alpha != 1.f) != 0ull) {
#pragma unroll
                for (int db = 0; db < 8; ++db) oacc[db] *= alpha;
            }
#pragma unroll
            for (int hf = 0; hf < 2; ++hf) {
                u32x4 pw; pw.x = cvt_pk_bf16(pv[8 * hf], pv[8 * hf + 1]); pw.y = cvt_pk_bf16(pv[8 * hf + 2], pv[8 * hf + 3]); pw.z = cvt_pk_bf16(pv[8 * hf + 4], pv[8 * hf + 5]); pw.w = cvt_pk_bf16(pv[8 * hf + 6], pv[8 * hf + 7]);
                const bf16x8 pf = __builtin_bit_cast(bf16x8, pw);
                const unsigned char* vb = sb + AT_KBYTES + r16 * AT_VPITCH + 2 * (32 * hf + 8 * g4);
#pragma unroll
                for (int db = 0; db < 8; ++db) {
                    const bf16x8 vf = *(const bf16x8*)(vb + 16 * db * AT_VPITCH);
                    oacc[db] = __builtin_amdgcn_mfma_f32_16x16x32_bf16(vf, pf, oacc[db], 0, 0, 0);
                }
            }
        };

        stage_load(0);
        __syncthreads();
        stage_store(0);
        __syncthreads();
        for (int rd = 0; rd < nrounds; ++rd) {
            if (rd + 1 < nrounds) stage_load(rd + 1);
            const unsigned char* sb = lds + (rd & 1) * AT_STAGE;
            if (rd < 4) chunk2(sb, 0, 0);
            else if (type == 0) {
                const int kr = na_krlo + (rd - 4);
                if (kr >= na_kr0 && kr <= na_kr0 + 7) chunk(sb, na_kc0, 1, kr - na_r + 7, 0);
            } else {
                const int kp0 = sw_base + 64 * (rd - 4), kp1 = kp0 + 32;
                const bool a0 = (kp0 + 31 >= sw_q0 - 128) && (kp0 <= sw_q0 + 15 + 128) && (kp0 + 31 >= 0) && (kp0 < SEQ);
                const bool a1 = (kp1 + 31 >= sw_q0 - 128) && (kp1 <= sw_q0 + 15 + 128) && (kp1 + 31 >= 0) && (kp1 < SEQ);
                if (a0 && a1) chunk2(sb, 2, kp0);
                else if (a0) chunk(sb, 0, 2, 0, kp0);
                else if (a1) chunk(sb, 32, 2, 0, kp1);
            }
            if (rd + 1 < nrounds) stage_store((rd + 1) & 1);
            __syncthreads();
        }
        float lt = l_run; lt += __shfl_xor(lt, 16); lt += __shfl_xor(lt, 32);
        const float inv = 1.f / lt;
        bf16_t* op = O + (size_t)(qrow0 + r16) * DM + ocol + 4 * g4;
#pragma unroll
        for (int db = 0; db < 8; ++db) { const f32x4 v = oacc[db] * inv; u32x2 w; w.x = cvt_pk_bf16(v[0], v[1]); w.y = cvt_pk_bf16(v[2], v[3]); *(u32x2*)(op + 16 * db) = w; }
    }
}

__device__ __forceinline__ int s5_pair_of(int b) { const int x = b & 7, slot = b >> 3, lg = x * 4 + (slot >> 3), member = slot & 7; return (member >> 2) * 128 + lg * 4 + (member & 3); }
constexpr int S5_PITCH = 36, S5_WAVE_BYTES = 2 * 64 * S5_PITCH * 4, S5_SEG_OFF = 8 * S5_WAVE_BYTES, S5_SEG_BYTES = 8 * 64 * 8, XB_LDS_OFF = S5_SEG_OFF + S5_SEG_BYTES;
__device__ void s5_pass1(const Params& p, unsigned char* lds, const float2* segbase, int seg_pair_stride) {
    constexpr int pass = 1;
    const int lane = threadIdx.x & 63, seg = threadIdx.x >> 6;
    float* UR = (float*)(lds + seg * S5_WAVE_BYTES);
    float* UI = UR + 64 * S5_PITCH;
    const bf16_t* H = (const bf16_t*)(p.ws + OFF_H);
    const float2* LAM = (const float2*)(p.ws + OFF_LAM); const float2* LAML = (const float2*)(p.ws + OFF_LAML);
    const bf16_t* BBT = (const bf16_t*)(p.ws + OFF_BBT); const bf16_t* CCM = (const bf16_t*)(p.ws + OFF_CCM);
    const int l31 = lane & 31, h5 = lane >> 5, r16 = lane & 15, g4 = lane >> 4;
    for (int bi = blockIdx.x; bi < 256; bi += gridDim.x) {
        const int pr = s5_pair_of(bi);
        const float2* SEGS = segbase + (size_t)pr * seg_pair_stride;
        const int dir = pr >> 7, g = pr & 127;
        float* Y = (float*)(p.ws + (dir == 0 ? OFF_YF : OFF_YB));
        const float2 lam = LAM[pr * 64 + lane];
        bf16x8 bbf[4], ccf[4];
#pragma unroll
        for (int nb = 0; nb < 4; ++nb) bbf[nb] = *(const bf16x8*)(BBT + ((size_t)pr * 128 + 32 * nb + l31) * 16 + 8 * h5);
#pragma unroll
        for (int ks = 0; ks < 4; ++ks) ccf[ks] = *(const bf16x8*)(CCM + ((size_t)pr * 16 + r16) * 128 + 32 * ks + 8 * g4);
        float sr = 0.f, si = 0.f;
        if (pass == 1) {
            const float2 lL = LAML[pr * 64 + lane];
            for (int j = 0; j < seg; ++j) { const float2 e = SEGS[j * 64 + lane]; const float nr = lL.x * sr - lL.y * si + e.x, ni = lL.x * si + lL.y * sr + e.y; sr = nr; si = ni; }
        }
        auto load_x = [&](int tile) -> bf16x8 {
            const int i = (seg * SEG_TILES + tile) * 32 + l31;
            const int row = (dir == 0) ? i : ((i < 256) ? 255 - i : 8703 - i);
            return *(const bf16x8*)(H + (size_t)row * DM + 16 * g + 8 * h5);
        };
        bf16x8 xnext = load_x(0);
        for (int tile = 0; tile < SEG_TILES; ++tile) {
            const int i0 = (seg * SEG_TILES + tile) * 32;
            {
                const bf16x8 xf = xnext;
                xnext = load_x(min(tile + 1, SEG_TILES - 1));
#pragma unroll
                for (int nb = 0; nb < 4; ++nb) {
                    f32x16 z;
#pragma unroll
                    for (int q = 0; q < 16; ++q) z[q] = 0.f;
                    const f32x16 a = __builtin_amdgcn_mfma_f32_32x32x16_bf16(xf, bbf[nb], z, 0, 0, 0);
                    float* up = ((nb < 2) ? UR : UI) + (32 * (nb & 1) + l31) * S5_PITCH + 4 * h5;
#pragma unroll
                    for (int k = 0; k < 4; ++k) *(f32x4*)(up + 8 * k) = (f32x4){a[4 * k], a[4 * k + 1], a[4 * k + 2], a[4 * k + 3]};
                }
            }
            asm volatile("s_waitcnt lgkmcnt(0)" ::: "memory"); __builtin_amdgcn_wave_barrier();
#pragma unroll
            for (int t0 = 0; t0 < 32; t0 += 8) {
                const f32x4 ur0 = *(const f32x4*)(UR + lane * S5_PITCH + t0), ur1 = *(const f32x4*)(UR + lane * S5_PITCH + t0 + 4);
                const f32x4 ui0 = *(const f32x4*)(UI + lane * S5_PITCH + t0), ui1 = *(const f32x4*)(UI + lane * S5_PITCH + t0 + 4);
                const float urv[8] = {ur0[0], ur0[1], ur0[2], ur0[3], ur1[0], ur1[1], ur1[2], ur1[3]};
                const float uiv[8] = {ui0[0], ui0[1], ui0[2], ui0[3], ui1[0], ui1[1], ui1[2], ui1[3]};
                unsigned sp[8];
#pragma unroll
                for (int j = 0; j < 8; ++j) {
                    const float nr = fmaf(lam.x, sr, fmaf(-lam.y, si, urv[j])), ni = fmaf(lam.x, si, fmaf(lam.y, sr, uiv[j]));
                    sr = nr; si = ni;
                    if (pass == 1) sp[j] = cvt_pk_bf16(sr, si);
                }
                if (pass == 1) {
                    *(u32x4*)(UR + lane * S5_PITCH + t0) = (u32x4){sp[0], sp[1], sp[2], sp[3]};
                    *(u32x4*)(UR + lane * S5_PITCH + t0 + 4) = (u32x4){sp[4], sp[5], sp[6], sp[7]};
                }
            }
            asm volatile("s_waitcnt lgkmcnt(0)" ::: "memory"); __builtin_amdgcn_wave_barrier();
            if (pass == 1 && i0 >= 256) {
                const unsigned* S = (const unsigned*)UR;
#pragma unroll
                for (int mb = 0; mb < 2; ++mb) {
                    f32x4 acc = {0.f, 0.f, 0.f, 0.f};
                    const int t = 16 * mb + r16;
#pragma unroll
                    for (int ks = 0; ks < 4; ++ks) {
                        const unsigned* sp0 = S + (16 * ks + 4 * g4) * S5_PITCH + t;
                        u32x4 sw; sw.x = sp0[0]; sw.y = sp0[S5_PITCH]; sw.z = sp0[2 * S5_PITCH]; sw.w = sp0[3 * S5_PITCH];
                        acc = __builtin_amdgcn_mfma_f32_16x16x32_bf16(ccf[ks], __builtin_bit_cast(bf16x8, sw), acc, 0, 0, 0);
                    }
                    const int i = i0 + t;
                    const int row = (dir == 0) ? i : 8703 - i;
                    *(f32x4*)(Y + (size_t)(row - 256) * DM + 16 * g + 4 * g4) = acc;
                }
                asm volatile("s_waitcnt lgkmcnt(0)" ::: "memory"); __builtin_amdgcn_wave_barrier();
            }
        }
    }
}
__device__ void s5_pass0_reg(const Params& p, float2* segbase, int seg_pair_stride) {
    const int lane = threadIdx.x & 63, seg = threadIdx.x >> 6;
    const bf16_t* H = (const bf16_t*)(p.ws + OFF_H);
    const float2* LAMPOW = (const float2*)(p.ws + OFF_LAMPOW); const float2* LAM32 = (const float2*)(p.ws + OFF_LAM32);
    const bf16_t* BBT = (const bf16_t*)(p.ws + OFF_BBT);
    const int l31 = lane & 31, h5 = lane >> 5;
    for (int bi = blockIdx.x; bi < 256; bi += gridDim.x) {
        const int pr = s5_pair_of(bi);
        const int dir = pr >> 7, g = pr & 127;
        bf16x8 bbf[4];
#pragma unroll
        for (int nb = 0; nb < 4; ++nb) bbf[nb] = *(const bf16x8*)(BBT + ((size_t)pr * 128 + 32 * nb + l31) * 16 + 8 * h5);
        float2 pw[2][16], l32[2];
#pragma unroll
        for (int q = 0; q < 2; ++q) {
            const int pp = 32 * q + l31;
            l32[q] = LAM32[pr * 64 + pp];
#pragma unroll
            for (int r = 0; r < 16; ++r) { const int t = (r & 3) + 8 * (r >> 2) + 4 * h5; pw[q][r] = LAMPOW[((size_t)pr * 64 + pp) * 32 + (31 - t)]; }
        }
        float sr[2] = {0.f, 0.f}, si[2] = {0.f, 0.f};
        auto load_x = [&](int tile) -> bf16x8 {
            const int i = (seg * SEG_TILES + tile) * 32 + l31;
            const int row = (dir == 0) ? i : ((i < 256) ? 255 - i : 8703 - i);
            return *(const bf16x8*)(H + (size_t)row * DM + 16 * g + 8 * h5);
        };
        bf16x8 xnext = load_x(0);
        for (int tile = 0; tile < SEG_TILES; ++tile) {
            const bf16x8 xf = xnext;
            xnext = load_x(min(tile + 1, SEG_TILES - 1));
#pragma unroll
            for (int q = 0; q < 2; ++q) {
                f32x16 z;
#pragma unroll
                for (int r = 0; r < 16; ++r) z[r] = 0.f;
                const f32x16 are = __builtin_amdgcn_mfma_f32_32x32x16_bf16(xf, bbf[q], z, 0, 0, 0);
                const f32x16 aim = __builtin_amdgcn_mfma_f32_32x32x16_bf16(xf, bbf[q + 2], z, 0, 0, 0);
                float er0 = 0.f, ei0 = 0.f, er1 = 0.f, ei1 = 0.f;
#pragma unroll
                for (int r = 0; r < 16; r += 2) {
                    er0 = fmaf(pw[q][r].x, are[r], fmaf(-pw[q][r].y, aim[r], er0)); ei0 = fmaf(pw[q][r].x, aim[r], fmaf(pw[q][r].y, are[r], ei0));
                    er1 = fmaf(pw[q][r + 1].x, are[r + 1], fmaf(-pw[q][r + 1].y, aim[r + 1], er1)); ei1 = fmaf(pw[q][r + 1].x, aim[r + 1], fmaf(pw[q][r + 1].y, are[r + 1], ei1));
                }
                float er = er0 + er1, ei = ei0 + ei1;
                er += __shfl_xor(er, 32); ei += __shfl_xor(ei, 32);
                const float nr = fmaf(l32[q].x, sr[q], fmaf(-l32[q].y, si[q], er)), ni = fmaf(l32[q].x, si[q], fmaf(l32[q].y, sr[q], ei));
                sr[q] = nr; si[q] = ni;
            }
        }
        if (h5 == 0) {
            float2* SEGL = segbase + (size_t)pr * seg_pair_stride;
            SEGL[seg * 64 + l31] = make_float2(sr[0], si[0]);
            SEGL[seg * 64 + 32 + l31] = make_float2(sr[1], si[1]);
        }
    }
}
__device__ void s5_combine(const Params& p) {
    const bf16_t* H = (const bf16_t*)(p.ws + OFF_H) + (size_t)256 * DM;
    const float* YF = (const float*)(p.ws + OFF_YF); const float* YB = (const float*)(p.ws + OFF_YB);
    bf16_t* AG = (bf16_t*)(p.ws + OFF_AG);
    const size_t n4 = (size_t)SEQ * DM / 4, stride = (size_t)gridDim.x * 512;
    for (size_t i = (size_t)blockIdx.x * 512 + threadIdx.x; i < n4; i += stride) {
        const int col = (int)((i * 4) & (DM - 1));
        const u32x2 hv = *(const u32x2*)(H + i * 4);
        const f32x4 yf = *(const f32x4*)(YF + i * 4), yb = *(const f32x4*)(YB + i * 4), dv = *(const f32x4*)(p.ssm_d + col);
        float hx[4] = {bf16_lo(hv.x), bf16_hi(hv.x), bf16_lo(hv.y), bf16_hi(hv.y)}, o[4];
#pragma unroll
        for (int j = 0; j < 4; ++j) {
            const float y = dv[j] * hx[j] + yf[j] + yb[j];
            const float z = 0.7978845608028654f * (y + 0.044715f * y * y * y);
            const float th = 1.f - 2.f / (1.f + __expf(2.f * z));
            o[j] = 0.5f * y * (1.f + th);
        }
        u32x2 w; w.x = cvt_pk_bf16(o[0], o[1]); w.y = cvt_pk_bf16(o[2], o[3]);
        *(u32x2*)(AG + i * 4) = w;
    }
}

__device__ __forceinline__ void ffn_block(const Params& p, const int layer, LAS unsigned char* ldsl, const XcdBarrier& xbar) {
    unsigned char* ws = p.ws;
    const int G = gridDim.x, cid = blockIdx.x;
    const float* modl = (const float*)(ws + OFF_MOD) + (size_t)layer * 2 * 12288;
    bf16_t* H = (bf16_t*)(ws + OFF_H); bf16_t* U = (bf16_t*)(ws + OFF_U);
    float* XA = (float*)(ws + OFF_XA); float* XB = (float*)(ws + OFF_XB); float* PART = (float*)(ws + OFF_PART);
    const int r0 = (layer == 0) ? 0 : 256, Mf = MROWS - r0;
    if (layer == 1) {
        norm_phase(p.ctx, XA + (size_t)256 * DM, r0, MROWS, p.norm_ffn + (size_t)layer * DM, modl, 4, 3, H, nullptr, 0, nullptr);
        xcd_barrier(xbar);
    }
    { pg8::Gemm g{H + (size_t)r0 * DM, (const bf16_t*)(ws + OFF_W13) + (size_t)layer * 2 * DFF * DM, Mf, 2 * DFF, DM}; pg8::StaticOrder S; S.init(Mf, 2 * DFF, DM, G, cid);
      EpiSwiGLU E{U + (size_t)r0 * DFF};
      const int full = (S.nwg / G) * G, rem = S.nwg - full;
      const bool tail = (layer == 1) && rem > 0 && 2 * rem <= G;
      if (tail) S.lim = full;
      pg8::gemm_phase<EpiSwiGLU, pg8::StaticOrder, true, true>(ldsl, g, S, E);
      if (layer == 1) { if (tail) {
          pg8::OneUnit T; T.so = S; T.L = (cid < 2 * rem) ? full + (cid >> 1) : -1; T.half = 1 + (cid & 1);
          if (cid & 1) pg8::gemm_phase<EpiSwiGLU, pg8::OneUnit, false, true, 2>(ldsl, g, T, E);
          else         pg8::gemm_phase<EpiSwiGLU, pg8::OneUnit, false, true, 1>(ldsl, g, T, E);
      } } }
    if (layer == 0) {
        const bool all = (G != 256);
        if (all || cid >= 172) ada_gemv(p, (unsigned char*)ldsl, 256, 512, all ? cid : cid - 172, all ? G : 84);
    }
    xcd_barrier(xbar);
    { pg8::Gemm g{U + (size_t)r0 * DFF, (const bf16_t*)(ws + OFF_W2) + (size_t)layer * DM * DFF, Mf, DM, DFF};
      if (layer == 0) {
          const float* modl1 = modl + 2 * 12288;
          pg8::CtxSplitOrder S; S.init(DM, DFF, G, cid);
          EpiResNormH E{XA + (size_t)256 * DM, modl + 12288 + 5 * DM, modl + 5 * DM, XB, PART, (float*)(ws + OFF_SSP), p.norm_mix + DM, modl1 + 1 * DM, modl1, H, &xbar};
          pg8::gemm_phase<EpiResNormH, pg8::CtxSplitOrder, false, true>(ldsl, g, S, E);
          norm_phase(XA, nullptr, 0, 256, p.norm_mix + DM, modl1, 1, 0, H, PART, 22, nullptr);
      }
      else {
          pg8::StaticOrder S; S.init(Mf, DM, DFF, G, cid);
          EpiResNorm EN{XA + (size_t)256 * DM, modl + 5 * DM, p.norm_final, p.out, PART, &xbar}; pg8::gemm_phase<EpiResNorm, pg8::StaticOrder, false, true>(ldsl, g, S, EN); } }
    if (layer == 0) xcd_barrier(xbar);
}

__global__ void __launch_bounds__(512, 2) fwd_megakernel(Params p) {
    extern __shared__ __attribute__((aligned(16))) unsigned char lds[];
    cg::grid_group grid = cg::this_grid();
    if (threadIdx.x == 0) *(uint4*)(lds + XB_LDS_OFF) = make_uint4(0u, 0u, 0u, 0u);
    __syncthreads();
    const XcdBarrier xbar = xcd_barrier_post((unsigned*)(p.ws + OFF_BAR), (volatile LAS unsigned*)((LAS unsigned char*)lds + XB_LDS_OFF));
    LAS unsigned char* ldsl = (LAS unsigned char*)lds;
    unsigned char* ws = p.ws;
    const int G = gridDim.x, cid = blockIdx.x;
    float* MOD = (float*)(ws + OFF_MOD);
    bf16_t* H = (bf16_t*)(ws + OFF_H); bf16_t* U = (bf16_t*)(ws + OFF_U);
    float* XA = (float*)(ws + OFF_XA); float* XB = (float*)(ws + OFF_XB); float* PART = (float*)(ws + OFF_PART);

#ifndef NO_P0
    p0_prologue(p, lds);
#endif
    if (p.ws == nullptr) grid.sync();
    xcd_barrier(xbar);

    {
        const float* modl = MOD;
        norm_phase(p.ctx, p.x, 0, MROWS, p.norm_mix, modl, 1, 0, H, nullptr, 0, nullptr);
        xcd_barrier(xbar);
        { pg8::Gemm g{H, (const bf16_t*)(ws + OFF_WQK), MROWS, NQK, DM}; pg8::StaticOrder S; S.init(MROWS, NQK, DM, G, cid);
          EpiQK E{(bf16_t*)(ws + OFF_QK), (const float2*)(ws + OFF_ROPE)}; pg8::gemm_phase<EpiQK, pg8::StaticOrder, true, true>(ldsl, g, S, E); }
        { pg8::Gemm g{(const bf16_t*)(ws + OFF_WV), H, NV, MROWS, DM}; pg8::StaticOrder S; S.init(NV, MROWS, DM, G, G - 1 - cid);
          EpiBf16Plain E{(bf16_t*)(ws + OFF_VT), MROWS}; pg8::gemm_phase<EpiBf16Plain, pg8::StaticOrder, true, true>(ldsl, g, S, E); }
        {
            const bool three = (G == 256) && (cid >= 91) && (cid < 173);
            if (!three) conv_tiles(p, CONV_L0_TILES, CONV_ALL_TILES, (G == 256) ? ((cid < 91) ? cid : cid - 82) : cid, (G == 256) ? 174 : G);
        }
        xcd_barrier(xbar);
#ifndef NO_ATTN
        attn_phase(p, lds);
#endif
        xcd_barrier(xbar);
        {
            pg8::Gemm g{(const bf16_t*)(ws + OFF_O), (const bf16_t*)(ws + OFF_WO), MROWS, DM, DM}; pg8::CtxSplitOrder S; S.init(DM, DM, G, cid);
            EpiResNormH E{p.x, modl + 12288 + 2 * DM, modl + 2 * DM, XA, PART, (float*)(ws + OFF_SSP), p.norm_ffn, modl + 4 * DM, modl + 3 * DM, H, &xbar};
            pg8::gemm_phase<EpiResNormH, pg8::CtxSplitOrder, false, true>(ldsl, g, S, E);
            norm_phase(p.ctx, nullptr, 0, 256, p.norm_ffn, modl, 4, 3, H, PART, 8, XA);
        }
        xcd_barrier(xbar);
        ffn_block(p, 0, ldsl, xbar);
    }
    {
        const float* modl = MOD + 2 * 12288;
        {
            const bool one = gridDim.x >= 256;
            float2* segbase = one ? (float2*)(lds + S5_SEG_OFF) : (float2*)(ws + OFF_SEG);
            const int sstride = one ? 0 : 512;
            s5_pass0_reg(p, segbase, sstride);
            if (one) __syncthreads(); else xcd_barrier(xbar);
            s5_pass1(p, lds, segbase, sstride);
        }
        xcd_barrier(xbar);
        s5_combine(p);
        xcd_barrier(xbar);
        { pg8::Gemm g{(const bf16_t*)(ws + OFF_AG), (const bf16_t*)(ws + OFF_WGLU), SEQ, 4096, DM}; pg8::StaticOrder S; S.init(SEQ, 4096, DM, G, cid);
          EpiGLU E{XB + (size_t)256 * DM, XA + (size_t)256 * DM, modl + 2 * DM, p.b_glu}; pg8::gemm_phase<EpiGLU, pg8::StaticOrder, true, true>(ldsl, g, S, E); }
        xcd_barrier(xbar);
        ffn_block(p, 1, ldsl, xbar);
    }
}

extern "C" void kernel_launch(void* const* d_in, const int* in_sizes, int n_in, void* d_out, int out_size, void* d_ws, size_t ws_size, hipStream_t stream) {
    constexpr int kDynLds = 8 * S5_WAVE_BYTES + S5_SEG_BYTES + 16;
    static_assert(kDynLds >= pg8::STAGE_BYTES, "LDS");
    static int grid_blocks = 0;
    if (!grid_blocks) {
        int dev = 0, cus = 0, per_cu = 0;
        hipGetDevice(&dev);
        hipDeviceGetAttribute(&cus, hipDeviceAttributeMultiprocessorCount, dev);
        hipFuncSetAttribute((const void*)fwd_megakernel, hipFuncAttributeMaxDynamicSharedMemorySize, kDynLds);
        hipOccupancyMaxActiveBlocksPerMultiprocessor(&per_cu, (const void*)fwd_megakernel, 512, kDynLds);
        if (per_cu < 1) { fprintf(stderr, "occupancy query returned %d\n", per_cu); per_cu = 1; }
        if (per_cu > 1) per_cu = 1;
        grid_blocks = cus * per_cu;
        if (grid_blocks > 256) grid_blocks = 256;
        if (grid_blocks != 256) fprintf(stderr, "this kernel is specialised for a 256-workgroup grid (got %d)\n", grid_blocks);
        if (ws_size < WS_END) fprintf(stderr, "workspace too small: %zu < %zu\n", ws_size, (size_t)WS_END);
    }
    Params p{};
    const float* const* in = (const float* const*)d_in;
    p.x = in[0]; p.c = in[1]; p.ctx = in[2]; p.c_ctx = in[3]; p.ada_w = in[4]; p.ada_b = in[5];
    p.norm_mix = in[6]; p.norm_ffn = in[7]; p.w1 = in[8]; p.w3 = in[9]; p.w2 = in[10];
    p.w_in = in[11]; p.w_out = in[12]; p.rpb = in[13]; p.sink = in[14];
    p.a_re = in[15]; p.a_im = in[16]; p.log_dt = in[17]; p.b_re = in[18]; p.b_im = in[19]; p.c_re = in[20]; p.c_im = in[21];
    p.ssm_d = in[22]; p.w_glu = in[23]; p.b_glu = in[24]; p.norm_final = in[25];
    p.out = (float*)d_out; p.ws = (unsigned char*)d_ws;
    hipMemsetAsync((unsigned char*)d_ws + OFF_BAR, 0, BAR_BYTES, stream);
    void* args[] = {&p};
    hipError_t e = hipLaunchCooperativeKernel((const void*)fwd_megakernel, dim3(grid_blocks), dim3(512), args, kDynLds, stream);
    if (e != hipSuccess) fprintf(stderr, "cooperative launch failed: %s (grid %d)\n", hipGetErrorString(e), grid_blocks);
}
```

```cpp
#include <hip/hip_runtime.h>
#include <hip/hip_cooperative_groups.h>
#include <cstdio>
namespace cg = cooperative_groups;

#define LAS __attribute__((address_space(3)))
typedef unsigned short bf16_t;
typedef short bf16x8 __attribute__((ext_vector_type(8)));
typedef float f32x4 __attribute__((ext_vector_type(4)));
typedef float f32x16 __attribute__((ext_vector_type(16)));
typedef unsigned u32x4 __attribute__((ext_vector_type(4)));
typedef unsigned u32x2 __attribute__((ext_vector_type(2)));

constexpr int DM = 2048, SEQ = 8192, CTXL = 256, MROWS = SEQ + CTXL, DFF = 5632;
constexpr int NQK = 3328, NV = 1280;
constexpr int SEG_TILES = 33, SEG_STEPS = SEG_TILES * 32;

constexpr size_t OFF_MOD  = 0;
constexpr size_t OFF_ROPE = OFF_MOD + 196608;
constexpr size_t OFF_LAM  = OFF_ROPE + 32768;
constexpr size_t OFF_LAML = OFF_LAM + 131072;
constexpr size_t OFF_BBT  = OFF_LAML + 131072;
constexpr size_t OFF_CCM  = OFF_BBT + 1048576;
constexpr size_t OFF_SEG  = OFF_CCM + 1048576;
constexpr size_t OFF_WQK  = OFF_SEG + 1048576;
constexpr size_t OFF_WV   = OFF_WQK + (size_t)NQK * DM * 2;
constexpr size_t OFF_WO   = OFF_WV + (size_t)NV * DM * 2;
constexpr size_t OFF_W13  = OFF_WO + (size_t)DM * DM * 2;
constexpr size_t OFF_W2   = OFF_W13 + (size_t)2 * 2 * DFF * DM * 2;
constexpr size_t OFF_WGLU = OFF_W2 + (size_t)2 * DM * DFF * 2;
constexpr size_t OFF_H    = OFF_WGLU + (size_t)4096 * DM * 2;
constexpr size_t OFF_QK   = OFF_H + (size_t)MROWS * DM * 2;
constexpr size_t OFF_VT   = OFF_QK + (size_t)MROWS * NQK * 2;
constexpr size_t OFF_O    = OFF_VT + (size_t)NV * MROWS * 2;
constexpr size_t OFF_XA   = OFF_O + (size_t)MROWS * DM * 2;
constexpr size_t OFF_XB   = OFF_XA + (size_t)MROWS * DM * 4;
constexpr size_t OFF_U    = OFF_XB + (size_t)MROWS * DM * 4;
constexpr size_t OFF_YB   = OFF_U + (size_t)MROWS * DFF * 2;
constexpr size_t OFF_BAR  = OFF_YB + (size_t)SEQ * DM * 4;
constexpr size_t BAR_BYTES = 16384;
constexpr size_t OFF_LAMPOW = OFF_BAR + BAR_BYTES;
constexpr size_t OFF_LAM32 = OFF_LAMPOW + (size_t)16384 * 32 * 8;
constexpr size_t WS_END   = OFF_LAM32 + 131072;
constexpr size_t OFF_YF   = OFF_QK;
constexpr size_t OFF_AG   = OFF_O;
constexpr size_t OFF_SSP  = OFF_YB + (size_t)48 * 1024 * 1024;
constexpr size_t OFF_PART = OFF_YB;
static_assert((size_t)SEQ * DM * 4 <= (size_t)MROWS * NQK * 2 + (size_t)NV * MROWS * 2, "YF alias");

struct Params {
    const float* x; const float* c; const float* ctx; const float* c_ctx; const float* ada_w; const float* ada_b;
    const float* norm_mix; const float* norm_ffn; const float* w1; const float* w3; const float* w2;
    const float* w_in; const float* w_out; const float* rpb; const float* sink;
    const float* a_re; const float* a_im; const float* log_dt; const float* b_re; const float* b_im; const float* c_re; const float* c_im;
    const float* ssm_d; const float* w_glu; const float* b_glu; const float* norm_final;
    float* out; unsigned char* ws;
};

__device__ __forceinline__ unsigned cvt_pk_bf16(float lo, float hi) { unsigned r; asm volatile("v_cvt_pk_bf16_f32 %0, %1, %2" : "=v"(r) : "v"(lo), "v"(hi)); return r; }
__device__ __forceinline__ float bf16_lo(unsigned u) { return __uint_as_float(u << 16); }
__device__ __forceinline__ float bf16_hi(unsigned u) { return __uint_as_float(u & 0xffff0000u); }
__device__ __forceinline__ float wave_sum(float v) {
#pragma unroll
    for (int o = 32; o >= 1; o >>= 1) v += __shfl_xor(v, o);
    return v;
}


#define XB_TMO      128
#define XB_XCNT(j)  (256  + 64 * (j))
#define XB_XSUB(j)  (1280 + 64 * (j))
#define XB_XGEN(j)  (2304 + 64 * (j))
#define XB_TOP      3328
#define XB_TOPGEN   3392
#define XCD_BAR_WORDS 3456
#define XB_SPIN_CAP (1u << 18)
__device__ __forceinline__ unsigned xb_ld(unsigned* p)              { return __hip_atomic_load(p, __ATOMIC_RELAXED, __HIP_MEMORY_SCOPE_AGENT); }
__device__ __forceinline__ unsigned xb_add(unsigned* p, unsigned v) { return __hip_atomic_fetch_add(p, v, __ATOMIC_RELAXED, __HIP_MEMORY_SCOPE_AGENT); }
__device__ __forceinline__ unsigned xb_xcc_id() { return (unsigned)__builtin_amdgcn_s_getreg((3 << 11) | 20) & 0xFu; }
#define XB_SPIN(cond, bar) do { unsigned _sp = 0; while (cond) { __builtin_amdgcn_s_sleep(1); \
    if ((++_sp & 255u) == 0u) { if (xb_ld(&(bar)[XB_TMO])) break; if (_sp > XB_SPIN_CAP) { atomicAdd(&(bar)[XB_TMO], 1u); break; } } } } while (0)
struct XcdBarrier { unsigned* bar; unsigned x; volatile LAS unsigned* st; };
__device__ __forceinline__ XcdBarrier xcd_barrier_post(unsigned* bar, volatile LAS unsigned* st) {
    XcdBarrier b; b.bar = bar; b.x = xb_xcc_id(); b.st = st;
    if (threadIdx.x == 0) (void)xb_add(&bar[XB_XCNT(b.x)], 1u);
    return b;
}
__device__ __forceinline__ void xcd_barrier_complete(unsigned* bar, unsigned x, unsigned& nloc, unsigned& nx) {
    const unsigned G = gridDim.x * gridDim.y * gridDim.z;
    unsigned sum, cnt, mine, sp = 0u;
    for (;;) {
        sum = 0u; cnt = 0u; mine = 0u;
#pragma unroll
        for (unsigned j = 0; j < 16; ++j) { const unsigned c = xb_ld(&bar[XB_XCNT(j)]); sum += c; cnt += (c > 0u) ? 1u : 0u; mine = (j == x) ? c : mine; }
        if (sum == G) break;
        __builtin_amdgcn_s_sleep(1);
        if ((++sp & 255u) == 0u) { if (xb_ld(&bar[XB_TMO])) break; if (sp > XB_SPIN_CAP) { atomicAdd(&bar[XB_TMO], 1u); break; } }
    }
    nloc = mine > 0u ? mine : 1u; nx = cnt > 0u ? cnt : 1u;
}
__device__ __forceinline__ void xcd_barrier(const XcdBarrier& b) {
    asm volatile("s_waitcnt vmcnt(0)" ::: "memory");
    __syncthreads();
    if (threadIdx.x == 0) {
        unsigned* bar = b.bar;
        __builtin_amdgcn_s_waitcnt(0);
        unsigned nloc = b.st[0], nx = b.st[1];
        if (nloc == 0u) { xcd_barrier_complete(bar, b.x, nloc, nx); b.st[0] = nloc; b.st[1] = nx; }
        const unsigned old = xb_add(&bar[XB_XSUB(b.x)], 1u);
        const unsigned gen = old / nloc;
        if (old + 1u == (gen + 1u) * nloc) {
            __builtin_amdgcn_fence(__ATOMIC_RELEASE, "agent");
            asm volatile("s_waitcnt vmcnt(0)" ::: "memory");
            const unsigned og = xb_add(&bar[XB_TOP], 1u);
            const unsigned tg = og / nx;
            if (og + 1u == (tg + 1u) * nx) xb_add(&bar[XB_TOPGEN], 1u);
            else XB_SPIN(xb_ld(&bar[XB_TOPGEN]) == tg, bar);
            __builtin_amdgcn_fence(__ATOMIC_ACQUIRE, "agent");
            xb_add(&bar[XB_XGEN(b.x)], 1u);
            asm volatile("s_waitcnt vmcnt(0)" ::: "memory");
        } else {
            XB_SPIN(xb_ld(&bar[XB_XGEN(b.x)]) == gen, bar);
            __builtin_amdgcn_fence(__ATOMIC_ACQUIRE, "agent");
            asm volatile("s_waitcnt vmcnt(0)" ::: "memory");
        }
    }
    __syncthreads();
}

namespace pg8 {
constexpr int BM = 256, BK = 64, HALF = 128, HTB = HALF * BK * 2, STAGE_BYTES = 8 * HTB, NXCD = 8, WGM = 8;
__host__ __device__ __forceinline__ int lds_byte(int r, int c) { const int st = (r >> 4) * 2 + (c >> 5), rr = r & 15, cc = c & 31, ob = rr * 64 + cc * 2; return st * 1024 + (ob ^ (((ob >> 9) & 1) << 5)); }
__host__ __device__ __forceinline__ void stage_rc(int b, int& R, int& C) { const int st = b / 1024, sb = b % 1024, swz = sb ^ (((sb >> 9) & 1) << 5); R = (st >> 1) * 16 + swz / 64; C = (st & 1) * 32 + (swz % 64) / 2; }
struct Unit { int pm, pn, kt0, nt, split, half; };
struct Gemm { const bf16_t* A; const bf16_t* Bt; int M, N, K; };
struct StaticOrder {
    int nM, nN, nwg, G, c, ntk, lim;
    __device__ void init(int M, int N, int K, int G_, int c_) { nM = M / BM; nN = N / BM; nwg = nM * nN; G = G_; c = c_; ntk = K / BK; lim = nwg; }
    __device__ bool next(int i, Unit& u) const { const long L = (long)i * G + c; if (L >= lim) return false; map((int)L, u); return true; }
    __device__ void map(int L, Unit& u) const {
        u.kt0 = 0; u.nt = ntk; u.split = 0; u.half = 0;
        int wgid = L; { const int q = nwg / NXCD, r = nwg % NXCD, xcd = wgid % NXCD, off = wgid / NXCD; wgid = (xcd < r ? xcd * (q + 1) : r * (q + 1) + (xcd - r) * q) + off; }
        const int nig = WGM * nN, gid = wgid / nig, fm = gid * WGM, gsz = (nM - fm) < WGM ? (nM - fm) : WGM;
        u.pm = fm + ((wgid % nig) % gsz); u.pn = (wgid % nig) / gsz;
    }
};
struct OneUnit {
    StaticOrder so; int L, half;
    __device__ bool next(int i, Unit& u) const { if (i != 0 || L < 0) return false; so.map(L, u); u.half = half; return true; }
};
struct CtxSplitOrder {
    StaticOrder so; int nsplit;
    __device__ void init(int N, int K, int G_, int c_) { so.init(8192, N, K, G_, c_); nsplit = (K / BK) / 4; }
    __device__ bool next(int i, Unit& u) const {
        const bool has_piece = so.c < so.nN * nsplit;
        if (has_piece && i == 0) { u.pm = 0; u.pn = so.c % so.nN; u.kt0 = (so.c / so.nN) * 4; u.nt = 4; u.split = 1; u.half = 0; return true; }
        if (i != (has_piece ? 1 : 0)) return false;
        if (!so.next(0, u)) return false;
        u.pm += 1; return true;
    }
};

template <class Epi, class Sched, bool ALIGN_EPI = false, bool SP2 = false, int HPART = 0>
__device__ __forceinline__ void gemm_phase(LAS unsigned char* lds, const Gemm g, const Sched& S, const Epi& E) {
    int tid = threadIdx.x; asm volatile("" : "+v"(tid));
    const int wid = __builtin_amdgcn_readfirstlane(tid >> 6), lane = tid & 63, wr = wid >> 2, wc = wid & 3, fr = lane & 15, fq = lane >> 4;
    const int K = g.K;
    unsigned voffA[2];
#pragma unroll
    for (int i = 0; i < 2; ++i) { int R, C; stage_rc(tid * 16 + i * 8192, R, C); voffA[i] = (unsigned)(R * K + C) * 2u; }
    const size_t kstep = (size_t)(BK * 2);
    const size_t hstep = (size_t)HALF * K * 2;
    const size_t tstep = 2 * hstep;
    const unsigned ldsw = (unsigned)wid * 1024u;
    const int aoff = lds_byte(wr * 64 + fr, fq * 8), boff = lds_byte(wc * 32 + fr, fq * 8);
#define PG8_SA(b, h) (((b) * 2 + (h)) * HTB)
#define PG8_SB(b, h) ((4 + (b) * 2 + (h)) * HTB)
#define PG8_STAGE(bufoff, gbase) do { _Pragma("unroll") for (int _i = 0; _i < 2; ++_i) \
        __builtin_amdgcn_global_load_lds((const unsigned*)((const char*)(gbase) + voffA[_i]), (LAS unsigned*)(lds + (bufoff) + ldsw + _i * 8192), 16, 0, 0); } while (0)
#define PG8_LDA(dst, b, h) do { _Pragma("unroll") for (int m = 0; m < 4; ++m) _Pragma("unroll") for (int k = 0; k < 2; ++k) dst[m][k] = *(const LAS bf16x8*)(lds + PG8_SA(b, h) + aoff + m * 2048 + k * 1024); } while (0)
#define PG8_LDB(dst, b, h) do { _Pragma("unroll") for (int n = 0; n < 2; ++n) _Pragma("unroll") for (int k = 0; k < 2; ++k) dst[n][k] = *(const LAS bf16x8*)(lds + PG8_SB(b, h) + boff + n * 2048 + k * 1024); } while (0)
#define PG8_MMA(ai, bj, At, Bt) do { __builtin_amdgcn_s_setprio(1); _Pragma("unroll") for (int m = 0; m < 4; ++m) _Pragma("unroll") for (int n = 0; n < 2; ++n) _Pragma("unroll") for (int k = 0; k < 2; ++k) \
        acc[ai][bj][m][n] = __builtin_amdgcn_mfma_f32_16x16x32_bf16(Bt[n][k], At[m][k], acc[ai][bj][m][n], 0, 0, 0); __builtin_amdgcn_s_setprio(0); } while (0)
#define PG8_WAIT_V(n) asm volatile("s_waitcnt vmcnt(" #n ")" ::: "memory")
#define PG8_WAIT_L(n) asm volatile("s_waitcnt lgkmcnt(" #n ")" ::: "memory")
#define PG8_BAR __builtin_amdgcn_s_barrier()
#define PG8_SCHED __builtin_amdgcn_sched_barrier(0)
    Unit cur, nxt; int ui = 0;
    if (!S.next(0, cur)) return;
    f32x4 acc[2][2][4][2];
#pragma unroll
    for (int a = 0; a < 2; ++a)
#pragma unroll
        for (int b = 0; b < 2; ++b)
#pragma unroll
            for (int m = 0; m < 4; ++m)
#pragma unroll
                for (int n = 0; n < 2; ++n) acc[a][b][m][n] = (f32x4){0.f, 0.f, 0.f, 0.f};
    bf16x8 At[4][2], B0[2][2], B1[2][2];
    const char* cA = (const char*)g.A + (size_t)cur.pm * tstep + (size_t)cur.kt0 * kstep; const char* cB = (const char*)g.Bt + (size_t)cur.pn * tstep + (size_t)cur.kt0 * kstep;
    if constexpr (SP2) {
        PG8_STAGE(PG8_SB(0, 0), cB); PG8_STAGE(PG8_SB(0, 1), cB + hstep); PG8_STAGE(PG8_SA(0, 0), cA); PG8_STAGE(PG8_SA(0, 1), cA + hstep);
        if (wr == 1) PG8_BAR;
        PG8_WAIT_V(2); PG8_BAR;
        PG8_STAGE(PG8_SB(1, 0), cB + kstep); PG8_STAGE(PG8_SA(1, 0), cA + kstep); PG8_STAGE(PG8_SB(1, 1), cB + hstep + kstep);
        PG8_WAIT_V(6); PG8_BAR;
    } else {
        PG8_STAGE(PG8_SB(0, 0), cB); PG8_STAGE(PG8_SA(0, 0), cA); PG8_STAGE(PG8_SB(0, 1), cB + hstep); PG8_STAGE(PG8_SA(0, 1), cA + hstep);
        if (wr == 1) PG8_BAR;
        PG8_WAIT_V(4); PG8_BAR;
        PG8_STAGE(PG8_SB(1, 0), cB + kstep); PG8_STAGE(PG8_SA(1, 0), cA + kstep); PG8_STAGE(PG8_SB(1, 1), cB + hstep + kstep);
        PG8_WAIT_V(6); PG8_BAR;
    }
    for (;;) {
        const bool has_next = S.next(ui + 1, nxt);
        const char* nA = has_next ? (const char*)g.A + (size_t)nxt.pm * tstep + (size_t)nxt.kt0 * kstep : cA; const char* nB = has_next ? (const char*)g.Bt + (size_t)nxt.pn * tstep + (size_t)nxt.kt0 * kstep : cB;
        const int nt = cur.nt;
        for (int t = 0; t < nt; t += 2) {
            const bool last = (t == nt - 2);
            const char* a1 = cA + (size_t)(t + 1) * kstep;
            const char* a2 = last ? nA : cA + (size_t)(t + 2) * kstep; const char* b2 = last ? nB : cB + (size_t)(t + 2) * kstep;
            const char* a3 = a2 + kstep; const char* b3 = b2 + kstep;
            if constexpr (SP2) {
            PG8_LDB(B0, 0, 0); PG8_LDB(B1, 0, 1); PG8_SCHED; PG8_LDA(At, 0, 0); PG8_STAGE(PG8_SA(1, 1), a1 + hstep);
            PG8_WAIT_V(8); PG8_WAIT_L(0); PG8_BAR; if constexpr (HPART != 2) { PG8_MMA(0, 0, At, B0); PG8_MMA(0, 1, At, B1); } PG8_BAR; PG8_SCHED;
            PG8_LDA(At, 0, 1); PG8_STAGE(PG8_SB(0, 0), b2); PG8_STAGE(PG8_SB(0, 1), b2 + hstep); PG8_STAGE(PG8_SA(0, 0), a2);
            PG8_WAIT_V(8); PG8_WAIT_L(0); PG8_BAR; if constexpr (HPART != 1) { PG8_MMA(1, 0, At, B0); PG8_MMA(1, 1, At, B1); } PG8_BAR; PG8_SCHED;
            PG8_LDB(B0, 1, 0); PG8_LDB(B1, 1, 1); PG8_SCHED; PG8_LDA(At, 1, 0); PG8_STAGE(PG8_SA(0, 1), a2 + hstep);
            PG8_WAIT_V(8); PG8_WAIT_L(0); PG8_BAR; if constexpr (HPART != 2) { PG8_MMA(0, 0, At, B0); PG8_MMA(0, 1, At, B1); } PG8_BAR; PG8_SCHED;
            PG8_LDA(At, 1, 1); PG8_STAGE(PG8_SB(1, 0), b3); PG8_STAGE(PG8_SB(1, 1), b3 + hstep); PG8_STAGE(PG8_SA(1, 0), a3);
            PG8_WAIT_V(8); PG8_WAIT_L(0); PG8_BAR; if constexpr (HPART != 1) { PG8_MMA(1, 0, At, B0); PG8_MMA(1, 1, At, B1); } PG8_BAR; PG8_SCHED;
            } else {
            PG8_LDB(B0, 0, 0); PG8_SCHED; PG8_LDA(At, 0, 0); PG8_STAGE(PG8_SA(1, 1), a1 + hstep);
            PG8_WAIT_L(8); PG8_BAR; PG8_WAIT_L(0); PG8_MMA(0, 0, At, B0); PG8_BAR; PG8_SCHED;
            PG8_LDB(B1, 0, 1); PG8_STAGE(PG8_SB(0, 0), b2);
            PG8_BAR; PG8_WAIT_L(0); PG8_MMA(0, 1, At, B1); PG8_BAR;
            PG8_LDA(At, 0, 1); PG8_STAGE(PG8_SA(0, 0), a2);
            PG8_BAR; PG8_WAIT_L(0); PG8_MMA(1, 0, At, B0); PG8_BAR; PG8_SCHED;
            PG8_STAGE(PG8_SB(0, 1), b2 + hstep);
            PG8_WAIT_V(6); PG8_BAR; PG8_MMA(1, 1, At, B1); PG8_BAR;
            PG8_LDB(B0, 1, 0); PG8_SCHED; PG8_LDA(At, 1, 0); PG8_STAGE(PG8_SA(0, 1), a2 + hstep);
            PG8_WAIT_L(8); PG8_BAR; PG8_WAIT_L(0); PG8_MMA(0, 0, At, B0); PG8_BAR; PG8_SCHED;
            PG8_LDB(B1, 1, 1); PG8_STAGE(PG8_SB(1, 0), b3);
            PG8_BAR; PG8_WAIT_L(0); PG8_MMA(0, 1, At, B1); PG8_BAR;
            PG8_LDA(At, 1, 1); PG8_STAGE(PG8_SA(1, 0), a3);
            PG8_BAR; PG8_WAIT_L(0); PG8_MMA(1, 0, At, B0); PG8_BAR; PG8_SCHED;
            PG8_STAGE(PG8_SB(1, 1), b3 + hstep);
            PG8_WAIT_V(6); PG8_BAR; PG8_MMA(1, 1, At, B1); PG8_BAR;
            }
        }
        if constexpr (ALIGN_EPI) { if (wr == 0) PG8_BAR; }
        if constexpr (!Epi::AFTER_DRAIN) E(acc, cur, wr, wc, fr, fq); else { if (cur.split) E(acc, cur, wr, wc, fr, fq); }
        if (!has_next) break;
#pragma unroll
        for (int a = 0; a < 2; ++a)
#pragma unroll
            for (int b = 0; b < 2; ++b)
#pragma unroll
                for (int m = 0; m < 4; ++m)
#pragma unroll
                    for (int n = 0; n < 2; ++n) acc[a][b][m][n] = (f32x4){0.f, 0.f, 0.f, 0.f};
        cur = nxt; cA = nA; cB = nB; ++ui;
        if constexpr (ALIGN_EPI) { if (wr == 1) PG8_BAR; }
    }
    PG8_WAIT_V(0);
    if constexpr (!ALIGN_EPI) { if (wr == 0) PG8_BAR; }
    PG8_BAR;
    if constexpr (Epi::AFTER_DRAIN) E.fused(acc, cur, wr, wc, fr, fq, lds);
#undef PG8_SA
#undef PG8_SB
#undef PG8_STAGE
#undef PG8_LDA
#undef PG8_LDB
#undef PG8_MMA
#undef PG8_WAIT_V
#undef PG8_WAIT_L
#undef PG8_BAR
#undef PG8_SCHED
}
}

typedef const f32x4 (&AccRef)[2][2][4][2];

struct EpiQK {
    static constexpr bool AFTER_DRAIN = false;
    bf16_t* QK; const float2* rope;
    __device__ __forceinline__ void operator()(AccRef acc, const pg8::Unit& u, int wr, int wc, int fr, int fq) const {
#pragma unroll
        for (int ai = 0; ai < 2; ++ai)
#pragma unroll
            for (int m = 0; m < 4; ++m) {
                const int row = u.pm * 256 + ai * 128 + wr * 64 + m * 16 + fr;
                bf16_t* rowp = QK + (size_t)row * NQK;
#pragma unroll
                for (int bj = 0; bj < 2; ++bj) {
                    const int cbase = u.pn * 256 + bj * 128 + wc * 32;
                    if (cbase < 2048) {
#pragma unroll
                        for (int n = 0; n < 2; ++n) { const f32x4 v = acc[ai][bj][m][n]; u32x2 w; w.x = cvt_pk_bf16(v[0], v[1]); w.y = cvt_pk_bf16(v[2], v[3]); *(u32x2*)(rowp + cbase + 16 * n + 4 * fq) = w; }
                    } else {
                        const int blk64 = cbase >> 6, wcl = (cbase >> 5) & 1;
                        f32x4 x1 = acc[ai][bj][m][0], x2 = acc[ai][bj][m][1], o1 = x1, o2 = x2;
                        if (row >= 256) {
                            const int t = row - 256, pos = (blk64 & 1) ? (t & 63) : (t >> 6);
                            const float2* rp = rope + pos * 32 + 16 * wcl + 4 * fq;
#pragma unroll
                            for (int i = 0; i < 4; ++i) { const float2 cs = rp[i]; o1[i] = x1[i] * cs.x - x2[i] * cs.y; o2[i] = x2[i] * cs.x + x1[i] * cs.y; }
                        }
                        bf16_t* dp = rowp + 64 * blk64 + 16 * wcl + 4 * fq;
                        u32x2 w; w.x = cvt_pk_bf16(o1[0], o1[1]); w.y = cvt_pk_bf16(o1[2], o1[3]); *(u32x2*)dp = w;
                        w.x = cvt_pk_bf16(o2[0], o2[1]); w.y = cvt_pk_bf16(o2[2], o2[3]); *(u32x2*)(dp + 32) = w;
                    }
                }
            }
    }
};
struct EpiBf16Plain {
    static constexpr bool AFTER_DRAIN = false;
    bf16_t* O; int ldc;
    __device__ __forceinline__ void operator()(AccRef acc, const pg8::Unit& u, int wr, int wc, int fr, int fq) const {
#pragma unroll
        for (int ai = 0; ai < 2; ++ai)
#pragma unroll
            for (int m = 0; m < 4; ++m) {
                const int row = u.pm * 256 + ai * 128 + wr * 64 + m * 16 + fr;
                bf16_t* rowp = O + (size_t)row * ldc + u.pn * 256 + wc * 32 + 4 * fq;
#pragma unroll
                for (int bj = 0; bj < 2; ++bj)
#pragma unroll
                    for (int n = 0; n < 2; ++n) { const f32x4 v = acc[ai][bj][m][n]; u32x2 w; w.x = cvt_pk_bf16(v[0], v[1]); w.y = cvt_pk_bf16(v[2], v[3]); *(u32x2*)(rowp + bj * 128 + 16 * n) = w; }
            }
    }
};
struct EpiRes {
    static constexpr bool AFTER_DRAIN = false;
    const float* base0; const float* base1; float* out; const float* gate0; const float* gate1; int rowoff; float* part;
    __device__ __forceinline__ void operator()(AccRef acc, const pg8::Unit& u, int wr, int wc, int fr, int fq) const {
        const int col0 = u.pn * 256 + wc * 32 + 4 * fq;
        const bool isctx = (u.pm * 256 + rowoff) < 256;
        const float* gate = isctx ? gate0 : gate1;
        f32x4 gv[2][2];
#pragma unroll
        for (int bj = 0; bj < 2; ++bj)
#pragma unroll
            for (int n = 0; n < 2; ++n) gv[bj][n] = *(const f32x4*)(gate + col0 + bj * 128 + n * 16);
        const int grow0 = u.pm * 256 + wr * 64 + fr + rowoff;
        if (u.split) {
            float* pbase = part + ((size_t)(u.kt0 >> 2) * 256 + wr * 64 + fr) * DM + col0;
#pragma unroll
            for (int ai = 0; ai < 2; ++ai)
#pragma unroll
                for (int m = 0; m < 4; ++m) {
                    float* op = pbase + (size_t)(ai * 128 + m * 16) * DM;
#pragma unroll
                    for (int bj = 0; bj < 2; ++bj)
#pragma unroll
                        for (int n = 0; n < 2; ++n) *(f32x4*)(op + bj * 128 + n * 16) = gv[bj][n] * acc[ai][bj][m][n];
                }
            return;
        }
#pragma unroll
        for (int ai = 0; ai < 2; ++ai)
#pragma unroll
            for (int m = 0; m < 4; ++m) {
                const int grow = grow0 + ai * 128 + m * 16;
                const float* bp = (isctx ? base0 + (size_t)grow * DM : base1 + (size_t)(grow - 256) * DM) + col0;
                float* op = out + (size_t)grow * DM + col0;
#pragma unroll
                for (int bj = 0; bj < 2; ++bj)
#pragma unroll
                    for (int n = 0; n < 2; ++n) { const f32x4 b = *(const f32x4*)(bp + bj * 128 + n * 16); *(f32x4*)(op + bj * 128 + n * 16) = b + gv[bj][n] * acc[ai][bj][m][n]; }
            }
    }
};
struct EpiResNormH {
    static constexpr bool AFTER_DRAIN = true;
    const float* base1; const float* gate0; const float* gate1; float* outf; float* part; float* ssp; const float* nw; const float* sc; const float* sh; bf16_t* H; const XcdBarrier* xbar;
    __device__ __forceinline__ void operator()(AccRef acc, const pg8::Unit& u, int wr, int wc, int fr, int fq) const {
        const int col0 = u.pn * 256 + wc * 32 + 4 * fq;
        float* pbase = part + ((size_t)(u.kt0 >> 2) * 256 + wr * 64 + fr) * DM + col0;
#pragma unroll
        for (int bj = 0; bj < 2; ++bj)
#pragma unroll
            for (int n = 0; n < 2; ++n) {
                const f32x4 gvv = *(const f32x4*)(gate0 + col0 + bj * 128 + n * 16);
#pragma unroll
                for (int ai = 0; ai < 2; ++ai)
#pragma unroll
                    for (int m = 0; m < 4; ++m) *(f32x4*)(pbase + (size_t)(ai * 128 + m * 16) * DM + bj * 128 + n * 16) = gvv * acc[ai][bj][m][n];
            }
    }
    __device__ __forceinline__ void fused(f32x4 (&acc)[2][2][4][2], const pg8::Unit& u, int wr, int wc, int fr, int fq, LAS unsigned char* ldsl) const {
        float* ssl = (float*)ldsl;
        float* rsl = ssl + 1024;
        const int col0 = u.pn * 256 + wc * 32 + 4 * fq, rl0 = wr * 64 + fr, pml = u.pm - 1;
        {
            f32x4 gv[2][2];
#pragma unroll
            for (int bj = 0; bj < 2; ++bj)
#pragma unroll
                for (int n = 0; n < 2; ++n) gv[bj][n] = *(const f32x4*)(gate1 + col0 + bj * 128 + n * 16);
#pragma unroll
            for (int ai = 0; ai < 2; ++ai)
#pragma unroll
                for (int m = 0; m < 4; ++m) {
                    const int rl = rl0 + ai * 128 + m * 16;
                    const float* bp = base1 + (size_t)(pml * 256 + rl) * DM + col0;
                    float* op = outf + (size_t)(u.pm * 256 + rl) * DM + col0;
                    float ss = 0.f;
#pragma unroll
                    for (int bj = 0; bj < 2; ++bj)
#pragma unroll
                        for (int n = 0; n < 2; ++n) {
                            const f32x4 v = *(const f32x4*)(bp + bj * 128 + n * 16) + gv[bj][n] * acc[ai][bj][m][n];
                            acc[ai][bj][m][n] = v;
                            *(f32x4*)(op + bj * 128 + n * 16) = v;
                            ss += v[0] * v[0] + v[1] * v[1] + v[2] * v[2] + v[3] * v[3];
                        }
                    ss += __shfl_xor(ss, 16); ss += __shfl_xor(ss, 32);
                    if (fq == 0) ssl[rl * 4 + wc] = ss;
                }
        }
        __syncthreads();
        if (threadIdx.x < 256) { const int r = threadIdx.x; ssp[((size_t)pml * 8 + u.pn) * 256 + r] = ssl[r * 4] + ssl[r * 4 + 1] + ssl[r * 4 + 2] + ssl[r * 4 + 3]; }
        xcd_barrier(*xbar);
        if (threadIdx.x < 256) {
            const int r = threadIdx.x; float tot = 0.f;
#pragma unroll
            for (int pn = 0; pn < 8; ++pn) tot += ssp[((size_t)pml * 8 + pn) * 256 + r];
            rsl[r] = rsqrtf(tot * (1.f / DM) + 1e-6f);
        }
        __syncthreads();
#pragma unroll
        for (int bj = 0; bj < 2; ++bj)
#pragma unroll
            for (int n = 0; n < 2; ++n) {
                const int col = col0 + bj * 128 + n * 16;
                const f32x4 w4 = *(const f32x4*)(nw + col), sc4 = *(const f32x4*)(sc + col), sh4 = *(const f32x4*)(sh + col);
                const f32x4 ws4 = w4 * (sc4 + 1.f);
#pragma unroll
                for (int ai = 0; ai < 2; ++ai)
#pragma unroll
                    for (int m = 0; m < 4; ++m) {
                        const int rl = rl0 + ai * 128 + m * 16;
                        const f32x4 o = acc[ai][bj][m][n] * rsl[rl] * ws4 + sh4;
                        u32x2 pk; pk.x = cvt_pk_bf16(o[0], o[1]); pk.y = cvt_pk_bf16(o[2], o[3]);
                        *(u32x2*)(H + (size_t)(u.pm * 256 + rl) * DM + col) = pk;
                    }
            }
    }
};
struct EpiResNorm {
    static constexpr bool AFTER_DRAIN = true;
    const float* base1; const float* gate1; const float* nw; float* out; float* ssp; const XcdBarrier* xbar;
    __device__ __forceinline__ void operator()(AccRef, const pg8::Unit&, int, int, int, int) const {}
    __device__ __forceinline__ void fused(f32x4 (&acc)[2][2][4][2], const pg8::Unit& u, int wr, int wc, int fr, int fq, LAS unsigned char* ldsl) const {
        float* ssl = (float*)ldsl;
        float* rsl = ssl + 1024;
        const int col0 = u.pn * 256 + wc * 32 + 4 * fq, rl0 = wr * 64 + fr;
        f32x4 gv[2][2];
#pragma unroll
        for (int bj = 0; bj < 2; ++bj)
#pragma unroll
            for (int n = 0; n < 2; ++n) gv[bj][n] = *(const f32x4*)(gate1 + col0 + bj * 128 + n * 16);
#pragma unroll
        for (int ai = 0; ai < 2; ++ai)
#pragma unroll
            for (int m = 0; m < 4; ++m) {
                const int rl = rl0 + ai * 128 + m * 16;
                const float* bp = base1 + (size_t)(u.pm * 256 + rl) * DM + col0;
                float ss = 0.f;
#pragma unroll
                for (int bj = 0; bj < 2; ++bj)
#pragma unroll
                    for (int n = 0; n < 2; ++n) {
                        const f32x4 v = *(const f32x4*)(bp + bj * 128 + n * 16) + gv[bj][n] * acc[ai][bj][m][n];
                        acc[ai][bj][m][n] = v;
                        ss += v[0] * v[0] + v[1] * v[1] + v[2] * v[2] + v[3] * v[3];
                    }
                ss += __shfl_xor(ss, 16); ss += __shfl_xor(ss, 32);
                if (fq == 0) ssl[rl * 4 + wc] = ss;
            }
        __syncthreads();
        if (threadIdx.x < 256) { const int r = threadIdx.x; ssp[((size_t)u.pm * 8 + u.pn) * 256 + r] = ssl[r * 4] + ssl[r * 4 + 1] + ssl[r * 4 + 2] + ssl[r * 4 + 3]; }
        xcd_barrier(*xbar);
        if (threadIdx.x < 256) {
            const int r = threadIdx.x; float tot = 0.f;
#pragma unroll
            for (int pn = 0; pn < 8; ++pn) tot += ssp[((size_t)u.pm * 8 + pn) * 256 + r];
            rsl[r] = rsqrtf(tot * (1.f / DM) + 1e-6f);
        }
        __syncthreads();
        f32x4 wv[2][2];
#pragma unroll
        for (int bj = 0; bj < 2; ++bj)
#pragma unroll
            for (int n = 0; n < 2; ++n) wv[bj][n] = *(const f32x4*)(nw + col0 + bj * 128 + n * 16);
#pragma unroll
        for (int ai = 0; ai < 2; ++ai)
#pragma unroll
            for (int m = 0; m < 4; ++m) {
                const int rl = rl0 + ai * 128 + m * 16;
                const float r = rsl[rl];
                float* op = out + (size_t)(u.pm * 256 + rl) * DM + col0;
#pragma unroll
                for (int bj = 0; bj < 2; ++bj)
#pragma unroll
                    for (int n = 0; n < 2; ++n) *(f32x4*)(op + bj * 128 + n * 16) = acc[ai][bj][m][n] * r * wv[bj][n];
            }
    }
};
struct EpiSwiGLU {
    static constexpr bool AFTER_DRAIN = false;
    bf16_t* U;
    __device__ __forceinline__ void operator()(AccRef acc, const pg8::Unit& u, int wr, int wc, int fr, int fq) const {
#pragma unroll
        for (int ai = 0; ai < 2; ++ai) {
            if (u.half != 0 && u.half != ai + 1) continue;
#pragma unroll
            for (int m = 0; m < 4; ++m) {
                const int row = u.pm * 256 + ai * 128 + wr * 64 + m * 16 + fr;
                bf16_t* rowp = U + (size_t)row * DFF;
#pragma unroll
                for (int bj = 0; bj < 2; ++bj) {
                    const int G = (u.pn * 256 + bj * 128 + wc * 32) >> 5;
                    const f32x4 a = acc[ai][bj][m][0], b = acc[ai][bj][m][1]; float o[4];
#pragma unroll
                    for (int i = 0; i < 4; ++i) o[i] = a[i] * __builtin_amdgcn_rcpf(1.f + __expf(-a[i])) * b[i];
                    u32x2 w; w.x = cvt_pk_bf16(o[0], o[1]); w.y = cvt_pk_bf16(o[2], o[3]); *(u32x2*)(rowp + 16 * G + 4 * fq) = w;
                }
            }
        }
    }
};
struct EpiGLU {
    static constexpr bool AFTER_DRAIN = false;
    const float* base; float* out; const float* gate; const float* bglu;
    __device__ __forceinline__ void operator()(AccRef acc, const pg8::Unit& u, int wr, int wc, int fr, int fq) const {
#pragma unroll
        for (int bj = 0; bj < 2; ++bj) {
            const int G = (u.pn * 256 + bj * 128 + wc * 32) >> 5, col = 16 * G + 4 * fq;
            const f32x4 gv = *(const f32x4*)(gate + col), bv = *(const f32x4*)(bglu + col), bg = *(const f32x4*)(bglu + 2048 + col);
#pragma unroll
            for (int ai = 0; ai < 2; ++ai)
#pragma unroll
                for (int m = 0; m < 4; ++m) {
                    const int row = u.pm * 256 + ai * 128 + wr * 64 + m * 16 + fr;
                    const f32x4 b = *(const f32x4*)(base + (size_t)row * DM + col);
                    const f32x4 v = acc[ai][bj][m][0] + bv, gt = acc[ai][bj][m][1] + bg; f32x4 o;
#pragma unroll
                    for (int i = 0; i < 4; ++i) o[i] = b[i] + gv[i] * (v[i] * __builtin_amdgcn_rcpf(1.f + __expf(-gt[i])));
                    *(f32x4*)(out + (size_t)row * DM + col) = o;
                }
        }
    }
};

__device__ __forceinline__ void dsincos(double x, double& s, double& c) {
    const double kd = rint(x * 0.63661977236758134308);
    double r = fma(-kd, 1.57079632679489655800e+00, x);
    r = fma(-kd, 6.12323399573676603587e-17, r);
    const long long k = (long long)kd;
    const double r2 = r * r;
    const double sp = r * (1.0 + r2 * (-1.0 / 6.0 + r2 * (1.0 / 120.0 + r2 * (-1.0 / 5040.0 + r2 * (1.0 / 362880.0 + r2 * (-1.0 / 39916800.0 + r2 * (1.0 / 6227020800.0 + r2 * (-1.0 / 1307674368000.0))))))));
    const double cp = 1.0 + r2 * (-0.5 + r2 * (1.0 / 24.0 + r2 * (-1.0 / 720.0 + r2 * (1.0 / 40320.0 + r2 * (-1.0 / 3628800.0 + r2 * (1.0 / 479001600.0 + r2 * (-1.0 / 87178291200.0 + r2 * (1.0 / 20922789888000.0))))))));
    const int q = (int)(k & 3);
    s = (q == 0) ? sp : (q == 1) ? cp : (q == 2) ? -sp : -cp;
    c = (q == 0) ? cp : (q == 1) ? -sp : (q == 2) ? -cp : sp;
}
__device__ __forceinline__ int ropeperm(int p) { const int q = p & 63; return (p & ~63) + 32 * ((q & 31) >> 4) + 16 * (q >> 5) + (q & 15); }

constexpr int CONV_L0_TILES = 2944, CONV_ALL_TILES = 5568;
__device__ void conv_tiles(const Params& p, int t_begin, int t_end, int rank, int nranks) {
    unsigned char* ws = p.ws;
    int tid = threadIdx.x; asm volatile("" : "+v"(tid));
    const int wv = tid >> 6, ln = tid & 63;
    auto decode = [&](int tix, const float*& src, int& ld, bf16_t*& dst, int& K) {
        int local, Nd, kind; const float* s0; const float* s1; bf16_t* d0;
        if (tix < 416)        { local = tix;         Nd = NQK;  K = DM;  ld = 4608; kind = 0; s0 = p.w_in; s1 = s0; d0 = (bf16_t*)(ws + OFF_WQK); }
        else if (tix < 576)   { local = tix - 416;   Nd = NV;   K = DM;  ld = 4608; kind = 1; s0 = p.w_in; s1 = s0; d0 = (bf16_t*)(ws + OFF_WV); }
        else if (tix < 832)   { local = tix - 576;   Nd = DM;   K = DM;  ld = DM;   kind = 2; s0 = p.w_out; s1 = s0; d0 = (bf16_t*)(ws + OFF_WO); }
        else if (tix < 2240)  { local = tix - 832;   Nd = 2 * DFF; K = DM; ld = DFF; kind = 3; s0 = p.w1; s1 = p.w3; d0 = (bf16_t*)(ws + OFF_W13); }
        else if (tix < 2944)  { local = tix - 2240;  Nd = DM;   K = DFF; ld = DM;   kind = 2; s0 = p.w2; s1 = s0; d0 = (bf16_t*)(ws + OFF_W2); }
        else if (tix < 4352)  { local = tix - 2944;  Nd = 2 * DFF; K = DM; ld = DFF; kind = 3; s0 = p.w1 + (size_t)DM * DFF; s1 = p.w3 + (size_t)DM * DFF; d0 = (bf16_t*)(ws + OFF_W13) + (size_t)2 * DFF * DM; }
        else if (tix < 5056)  { local = tix - 4352;  Nd = DM;   K = DFF; ld = DM;   kind = 2; s0 = p.w2 + (size_t)DFF * DM; s1 = s0; d0 = (bf16_t*)(ws + OFF_W2) + (size_t)DM * DFF; }
        else                  { local = tix - 5056;  Nd = 4096; K = DM;  ld = 4096; kind = 4; s0 = p.w_glu; s1 = s0; d0 = (bf16_t*)(ws + OFF_WGLU); }
        const int nbn = Nd >> 8, kblk = local / nbn, nblk = local % nbn, k0 = kblk * 64 + 8 * (ln & 7), np = nblk * 256 + 32 * wv + 4 * (ln >> 3);
        const float* sp = s0; int col = np;
        if (kind == 0) { col = (np < 2048) ? np : (np < 3072) ? 3072 + ropeperm(np - 2048) : 4096 + ropeperm(np - 3072); }
        else if (kind == 1) { col = (np < 1024) ? 2048 + np : 4352 + (np - 1024); }
        else if (kind == 3) { const int G = np >> 5, r = np & 31; sp = (r < 16) ? s0 : s1; col = 16 * G + (r & 15); }
        else if (kind == 4) { const int G = np >> 5, r = np & 31; col = ((r < 16) ? 0 : 2048) + 16 * G + (r & 15); }
        src = sp + (size_t)k0 * ld + col;
        dst = d0 + (size_t)np * K + k0;
    };
    int tix = t_begin + rank;
    const float* src = nullptr; int ld = 0, K = 0; bf16_t* dst = nullptr;
    f32x4 cur[8];
    if (tix < t_end) {
        decode(tix, src, ld, dst, K);
#pragma unroll
        for (int j = 0; j < 8; ++j) cur[j] = *(const f32x4*)(src + (size_t)j * ld);
    }
    for (; tix < t_end; tix += nranks) {
        const int ntix = tix + nranks;
        const float* nsrc = src; int nld = ld, nK = K; bf16_t* ndst = dst;
        f32x4 nxt[8];
#pragma unroll
        for (int j = 0; j < 8; ++j) nxt[j] = (f32x4){0.f, 0.f, 0.f, 0.f};
        if (ntix < t_end) {
            decode(ntix, nsrc, nld, ndst, nK);
#pragma unroll
            for (int j = 0; j < 8; ++j) nxt[j] = *(const f32x4*)(nsrc + (size_t)j * nld);
        }
#pragma unroll
        for (int c = 0; c < 4; ++c) {
            u32x4 w; w.x = cvt_pk_bf16(cur[0][c], cur[1][c]); w.y = cvt_pk_bf16(cur[2][c], cur[3][c]); w.z = cvt_pk_bf16(cur[4][c], cur[5][c]); w.w = cvt_pk_bf16(cur[6][c], cur[7][c]);
            *(u32x4*)(dst + (size_t)c * K) = w;
        }
        src = nsrc; ld = nld; K = nK; dst = ndst;
#pragma unroll
        for (int j = 0; j < 8; ++j) cur[j] = nxt[j];
    }
}

__device__ void ada_gemv(const Params& p, unsigned char* lds, int cb_begin, int cb_end, int rank, int nranks) {
    int tid = threadIdx.x; asm volatile("" : "+v"(tid));
    float* lf = (float*)lds;
    for (int i = tid; i < DM; i += 512) { const float a = p.c[i], b = p.c_ctx[i]; lf[i] = a / (1.f + __expf(-a)); lf[DM + i] = b / (1.f + __expf(-b)); }
    __syncthreads();
    float* part = lf + 2 * DM;
    float* MOD = (float*)(p.ws + OFF_MOD);
    for (int cb = cb_begin + rank; cb < cb_end; cb += nranks) {
        const int layer = cb >> 8, col0 = (cb & 255) * 48;
        if (tid < 384) {
            const int cgp = tid % 12, ks = tid / 12;
            const float* w = p.ada_w + (size_t)layer * DM * 12288 + (size_t)(ks * 64) * 12288 + col0 + 4 * cgp;
            f32x4 a0 = {0.f, 0.f, 0.f, 0.f}, a1 = {0.f, 0.f, 0.f, 0.f};
#pragma unroll 16
            for (int k = 0; k < 64; ++k) { const f32x4 wv = *(const f32x4*)(w + (size_t)k * 12288); const float s0 = lf[ks * 64 + k], s1 = lf[DM + ks * 64 + k]; a0 += s0 * wv; a1 += s1 * wv; }
            float* pp = part + (ks * 12 + cgp) * 8;
            *(f32x4*)pp = a0; *(f32x4*)(pp + 4) = a1;
        }
        __syncthreads();
        if (tid < 96) {
            const int cgp = tid >> 3, j = tid & 7, v = j >> 2, e = j & 3;
            float sacc = 0.f;
#pragma unroll
            for (int ks = 0; ks < 32; ++ks) sacc += part[(ks * 12 + cgp) * 8 + j];
            const int col = col0 + 4 * cgp + e;
            MOD[(layer * 2 + v) * 12288 + col] = sacc + p.ada_b[layer * 12288 + col];
        }
        __syncthreads();
    }
}

__device__ void p0_prologue(const Params& p, unsigned char* lds) {
    const int tid = threadIdx.x;
    float* lf = (float*)lds;
    unsigned char* ws = p.ws;
    ada_gemv(p, lds, 0, 256, blockIdx.x, gridDim.x);
    conv_tiles(p, 0, CONV_L0_TILES, blockIdx.x, gridDim.x);
    {
        const int gtid = blockIdx.x * 512 + tid, gstride = gridDim.x * 512;
        float2* rope = (float2*)(ws + OFF_ROPE);
        for (int idx = gtid; idx < 4096; idx += gstride) {
            const int pos = idx >> 5, j = idx & 31;
            const float inv = (float)exp(-(double)j / 32.0 * 9.210340371976184);
            const float ang = (float)pos * inv;
            double s, c; dsincos((double)ang, s, c);
            rope[idx] = make_float2((float)c, (float)s);
        }
        float2* LAM = (float2*)(ws + OFF_LAM); float2* LAML = (float2*)(ws + OFF_LAML);
        bf16_t* BBT = (bf16_t*)(ws + OFF_BBT); bf16_t* CCM = (bf16_t*)(ws + OFF_CCM);
        for (int idx = blockIdx.x * 64 + tid; tid < 64 && idx < 16384; idx += gridDim.x * 64) {
            const int pr = idx >> 6, pp = idx & 63;
            const double dt = exp((double)p.log_dt[pr]);
            const double ar = (double)p.a_re[idx], ai = (double)p.a_im[idx];
            const double mag = exp(ar * dt);
            double sn, cs; dsincos(ai * dt, sn, cs);
            const double lr = mag * cs, li = mag * sn;
            LAM[idx] = make_float2((float)lr, (float)li);
            const double magL = exp(ar * dt * (double)SEG_STEPS);
            double snL, csL; dsincos(ai * dt * (double)SEG_STEPS, snL, csL);
            LAML[idx] = make_float2((float)(magL * csL), (float)(magL * snL));
            const double den = ar * ar + ai * ai, nr = lr - 1.0;
            const double cr = (nr * ar + li * ai) / den, ci = (li * ar - nr * ai) / den;
            const float* br = p.b_re + (size_t)idx * 16; const float* bi = p.b_im + (size_t)idx * 16;
            bf16_t* d0 = BBT + ((size_t)pr * 128 + pp) * 16;
#pragma unroll
            for (int h = 0; h < 16; h += 2) {
                const double br0 = br[h], bi0 = bi[h], br1 = br[h + 1], bi1 = bi[h + 1];
                *(unsigned*)(d0 + h) = cvt_pk_bf16((float)(cr * br0 - ci * bi0), (float)(cr * br1 - ci * bi1));
                *(unsigned*)(d0 + 64 * 16 + h) = cvt_pk_bf16((float)(cr * bi0 + ci * br0), (float)(cr * bi1 + ci * br1));
            }
#pragma unroll
            for (int h = 0; h < 16; ++h) {
                const float cre = p.c_re[((size_t)pr * 16 + h) * 64 + pp], cim = p.c_im[((size_t)pr * 16 + h) * 64 + pp];
                *(unsigned*)(CCM + ((size_t)pr * 16 + h) * 128 + 2 * pp) = cvt_pk_bf16(cre, -cim);
            }
            {
                const double m32 = exp(ar * dt * 32.0); double s32, c32; dsincos(ai * dt * 32.0, s32, c32);
                ((float2*)(ws + OFF_LAM32))[idx] = make_float2((float)(m32 * c32), (float)(m32 * s32));
            }
        }
        for (int u = gtid; u < 16384 * 32; u += gstride) {
            const int idx = u >> 5, k = u & 31, pr = idx >> 6;
            const double dt = exp((double)p.log_dt[pr]), kd = (double)k;
            const double mg = exp((double)p.a_re[idx] * dt * kd);
            double sn, cs; dsincos((double)p.a_im[idx] * dt * kd, sn, cs);
            ((float2*)(ws + OFF_LAMPOW))[u] = make_float2((float)(mg * cs), (float)(mg * sn));
        }
    }
}

__device__ void norm_phase(const float* src0, const float* src1, int row_begin, int row_end, const float* nw, const float* modl, int sc_chunk, int sh_chunk, bf16_t* H,
                           const float* part, int npart, float* ctx_copy) {
    const int lane = threadIdx.x & 63, wave = threadIdx.x >> 6, gw = blockIdx.x * 8 + wave, nwv = gridDim.x * 8;
    const int n_ctx = (row_begin < 256) ? (256 - blockIdx.x + (int)gridDim.x - 1) / (int)gridDim.x : 0;
    const int lat0 = (row_begin < 256) ? 256 : row_begin;
    const int n_lat = (row_end - lat0 - gw + nwv - 1) / nwv;
    const int n_mine = ((wave == 0) ? n_ctx : 0) + (n_lat > 0 ? n_lat : 0);
    for (int it = 0; it < n_mine; ++it) {
        const bool isctx = (wave == 0) && (it < n_ctx);
        const int row = isctx ? (blockIdx.x + it * gridDim.x) : (lat0 + gw + (it - ((wave == 0) ? n_ctx : 0)) * nwv);
        const float* xr = isctx ? src0 + (size_t)row * DM : src1 + (size_t)(row - 256) * DM;
        const float* mv = modl + (isctx ? 12288 : 0);
        f32x4 xv[8];
#pragma unroll
        for (int i = 0; i < 8; ++i) xv[i] = *(const f32x4*)(xr + (i * 64 + lane) * 4);
        if (isctx) {
            for (int k = 0; k < npart; ++k) {
                const float* pr = part + ((size_t)k * 256 + row) * DM;
#pragma unroll
                for (int i = 0; i < 8; ++i) xv[i] += *(const f32x4*)(pr + (i * 64 + lane) * 4);
            }
            if (ctx_copy != nullptr) {
#pragma unroll
                for (int i = 0; i < 8; ++i) *(f32x4*)(ctx_copy + (size_t)row * DM + (i * 64 + lane) * 4) = xv[i];
            }
        }
        float ss = 0.f;
#pragma unroll
        for (int i = 0; i < 8; ++i) ss += xv[i][0] * xv[i][0] + xv[i][1] * xv[i][1] + xv[i][2] * xv[i][2] + xv[i][3] * xv[i][3];
        ss = wave_sum(ss);
        const float r = rsqrtf(ss * (1.f / DM) + 1e-6f);
#pragma unroll
        for (int i = 0; i < 8; ++i) {
            const int col = (i * 64 + lane) * 4;
            const f32x4 w = *(const f32x4*)(nw + col), sc = *(const f32x4*)(mv + sc_chunk * DM + col), sh = *(const f32x4*)(mv + sh_chunk * DM + col);
            float o[4];
#pragma unroll
            for (int j = 0; j < 4; ++j) o[j] = xv[i][j] * r * w[j] * (1.f + sc[j]) + sh[j];
            u32x2 pk; pk.x = cvt_pk_bf16(o[0], o[1]); pk.y = cvt_pk_bf16(o[2], o[3]);
            *(u32x2*)(H + (size_t)row * DM + col) = pk;
        }
    }
}
__device__ void final_norm_phase(const float* src, const float* nw, float* out) {
    const int lane = threadIdx.x & 63, gw = blockIdx.x * 8 + (threadIdx.x >> 6), nwv = gridDim.x * 8;
    for (int row = gw; row < SEQ; row += nwv) {
        const float* xr = src + (size_t)row * DM;
        f32x4 xv[8]; float ss = 0.f;
#pragma unroll
        for (int i = 0; i < 8; ++i) { xv[i] = *(const f32x4*)(xr + (i * 64 + lane) * 4); ss += xv[i][0] * xv[i][0] + xv[i][1] * xv[i][1] + xv[i][2] * xv[i][2] + xv[i][3] * xv[i][3]; }
        ss = wave_sum(ss);
        const float r = rsqrtf(ss * (1.f / DM) + 1e-6f);
#pragma unroll
        for (int i = 0; i < 8; ++i) { const int col = (i * 64 + lane) * 4; const f32x4 w = *(const f32x4*)(nw + col); *(f32x4*)(out + (size_t)row * DM + col) = xv[i] * r * w; }
    }
}

constexpr int AT_KBYTES = 64 * 256, AT_VPITCH = 144, AT_VBYTES = 128 * AT_VPITCH, AT_STAGE = AT_KBYTES + AT_VBYTES, AT_TBL_OFF = 2 * AT_STAGE;
static_assert(AT_TBL_OFF + 8 * 2048 <= 8 * 18432, "attention LDS");
__device__ void attn_phase(const Params& p, unsigned char* lds) {
    const int tid = threadIdx.x, lane = tid & 63, wave = tid >> 6;
    const int r16 = lane & 15, g4 = lane >> 4;
    const bf16_t* QK = (const bf16_t*)(p.ws + OFF_QK); const bf16_t* VT = (const bf16_t*)(p.ws + OFF_VT); bf16_t* O = (bf16_t*)(p.ws + OFF_O);
    constexpr float LOG2E = 1.4426950408889634f, SC2 = 0.08838834764831845f * 1.4426950408889634f, NEG = -1e30f;
    float* tbl = (float*)(lds + AT_TBL_OFF + wave * 2048);
    int tbl_head = -1;
    const int xcd = blockIdx.x & 7, bl = blockIdx.x >> 3, nbl = gridDim.x >> 3;
    int kkey[2], kdc[2], klds[2], vd[2], vj[2], vlds[2];
#pragma unroll
    for (int i = 0; i < 2; ++i) {
        const int u = tid + 512 * i;
        kkey[i] = u >> 4; kdc[i] = u & 15;
        const int swz = (kkey[i] & 3) | (((kkey[i] >> 3) & 3) << 2);
        klds[i] = kkey[i] * 256 + 16 * (kdc[i] ^ swz);
        vd[i] = u >> 3; vj[i] = u & 7; vlds[i] = AT_KBYTES + vd[i] * AT_VPITCH + 16 * vj[i];
    }
    for (int q = bl; q < 132; q += nbl) {
        int type, kcol, vrow0, nloc_rounds, loc_row0, loc_stride;
        int qrow0, qcol, ocol, hq = 0; bool has_sink = false;
        int na_h = 0, na_r = 0, na_kr0 = 0, na_kc0 = 0, na_qc = 0, na_krlo = 0, sw_q0 = 0, sw_base = 0;
        if (q < 64) {
            type = 0; na_h = xcd; const int r_lo = 2 * q; na_r = r_lo + (wave >> 2); const int n = wave & 3;
            kcol = 1024 + na_h * 128; vrow0 = na_h * 128;
            na_krlo = min(max(r_lo - 4, 0), 120); const int kr_hi = min(max(r_lo + 1 - 4, 0), 120) + 7;
            nloc_rounds = kr_hi - na_krlo + 1; loc_row0 = 256 + na_krlo * 64; loc_stride = 64;
            qrow0 = 256 + na_r * 64 + 16 * n; qcol = na_h * 128; ocol = na_h * 128;
            na_kr0 = min(max(na_r - 4, 0), 120); na_kc0 = min(max(16 * n - 8, 0), 32); na_qc = 16 * n + r16;
            if (tbl_head != na_h) {
                for (int i = lane; i < 465; i += 64) tbl[i] = p.rpb[na_h * 465 + i] * LOG2E;
                tbl_head = na_h;
            }
        } else if (q < 128) {
            type = 1; const int kvh = xcd >> 2, span = (xcd & 3) * 64 + (q - 64); hq = kvh * 4 + (wave & 3);
            kcol = 3072 + kvh * 128; vrow0 = 1024 + kvh * 128;
            sw_base = span * 32 - 128; nloc_rounds = 5; loc_row0 = 256 + sw_base; loc_stride = 64;
            sw_q0 = span * 32 + 16 * (wave >> 2); qrow0 = 256 + sw_q0; qcol = 2048 + hq * 128; ocol = 1024 + hq * 128; has_sink = true;
        } else {
            type = 2; const int id = xcd * 4 + (q - 128), hh = id >> 1, half = id & 1;
            nloc_rounds = 0; loc_row0 = 0; loc_stride = 0;
            qrow0 = 16 * (half * 8 + wave);
            if (hh < 8) { qcol = hh * 128; kcol = 1024 + hh * 128; vrow0 = hh * 128; ocol = hh * 128; }
            else { hq = hh - 8; qcol = 2048 + hq * 128; kcol = 3072 + (hq >> 2) * 128; vrow0 = 1024 + (hq >> 2) * 128; ocol = 1024 + hq * 128; has_sink = true; }
        }
        const int nrounds = 4 + nloc_rounds;
        bf16x8 qf[4];
        { const bf16_t* qp = QK + (size_t)(qrow0 + r16) * NQK + qcol + 8 * g4;
#pragma unroll
          for (int ks = 0; ks < 4; ++ks) qf[ks] = *(const bf16x8*)(qp + 32 * ks); }
        float m_run = has_sink ? p.sink[hq] * LOG2E : NEG;
        float l_run = (has_sink && g4 == 0) ? 1.f : 0.f;
        f32x4 oacc[8];
#pragma unroll
        for (int db = 0; db < 8; ++db) oacc[db] = (f32x4){0.f, 0.f, 0.f, 0.f};

        u32x4 stg[4];
        auto stage_load = [&](int rd) {
            const int row0 = (rd < 4) ? 64 * rd : loc_row0 + (rd - 4) * loc_stride;
#pragma unroll
            for (int i = 0; i < 2; ++i) {
                const int kr = min(row0 + kkey[i], MROWS - 1);
                stg[i] = *(const u32x4*)(QK + (size_t)kr * NQK + kcol + 8 * kdc[i]);
                const int vc = min(row0 + 8 * vj[i], MROWS - 8);
                stg[2 + i] = *(const u32x4*)(VT + (size_t)(vrow0 + vd[i]) * MROWS + vc);
            }
        };
        auto stage_store = [&](int buf) {
            unsigned char* sb = lds + buf * AT_STAGE;
#pragma unroll
            for (int i = 0; i < 2; ++i) { *(u32x4*)(sb + klds[i]) = stg[i]; *(u32x4*)(sb + vlds[i]) = stg[2 + i]; }
        };
        auto chunk = [&](const unsigned char* sb, int koff, int mode, int brow, int kpos0) {
            f32x4 sacc[2];
#pragma unroll
            for (int jb = 0; jb < 2; ++jb) {
                const int kap = koff + 8 * (r16 >> 2) + 4 * jb + (r16 & 3);
                const int swz = (kap & 3) | (((kap >> 3) & 3) << 2);
                const unsigned char* kb = sb + kap * 256;
                sacc[jb] = (f32x4){0.f, 0.f, 0.f, 0.f};
#pragma unroll
                for (int ks = 0; ks < 4; ++ks) {
                    const bf16x8 kf = *(const bf16x8*)(kb + 16 * ((4 * ks + g4) ^ swz));
                    sacc[jb] = __builtin_amdgcn_mfma_f32_16x16x32_bf16(kf, qf[ks], sacc[jb], 0, 0, 0);
                }
            }
            float s[8];
#pragma unroll
            for (int jb = 0; jb < 2; ++jb)
#pragma unroll
                for (int i = 0; i < 4; ++i) s[4 * jb + i] = sacc[jb][i] * SC2;
            if (mode == 1) {
                const int ws0 = min(max(na_qc - 8, 0), 48);
                const float* rp = tbl + brow * 31;
                float bias[8];
#pragma unroll
                for (int e = 0; e < 8; ++e) bias[e] = rp[min(max(na_kc0 + 8 * g4 + e - na_qc + 15, 0), 30)];
#pragma unroll
                for (int e = 0; e < 8; ++e) {
                    const int kc = na_kc0 + 8 * g4 + e;
                    const bool valid = (kc >= ws0) && (kc < ws0 + 16);
                    s[e] = valid ? s[e] + bias[e] : NEG;
                }
            } else if (mode == 2) {
                const int qpos = sw_q0 + r16;
#pragma unroll
                for (int e = 0; e < 8; ++e) {
                    const int kpos = kpos0 + 8 * g4 + e, d = kpos - qpos;
                    const bool valid = (kpos >= 0) && (kpos < SEQ) && (d <= 128) && (d >= -128);
                    s[e] = valid ? s[e] : NEG;
                }
            }
            float cm = fmaxf(fmaxf(fmaxf(s[0], s[1]), fmaxf(s[2], s[3])), fmaxf(fmaxf(s[4], s[5]), fmaxf(s[6], s[7])));
            cm = fmaxf(cm, __shfl_xor(cm, 16)); cm = fmaxf(cm, __shfl_xor(cm, 32));
            const float m_new = fmaxf(m_run, cm);
            const float alpha = __builtin_amdgcn_exp2f(m_run - m_new);
            float pv[8], ps = 0.f;
#pragma unroll
            for (int e = 0; e < 8; ++e) { pv[e] = __builtin_amdgcn_exp2f(s[e] - m_new); ps += pv[e]; }
            l_run = l_run * alpha + ps; m_run = m_new;
            u32x4 pw; pw.x = cvt_pk_bf16(pv[0], pv[1]); pw.y = cvt_pk_bf16(pv[2], pv[3]); pw.z = cvt_pk_bf16(pv[4], pv[5]); pw.w = cvt_pk_bf16(pv[6], pv[7]);
            const bf16x8 pf = __builtin_bit_cast(bf16x8, pw);
            const unsigned char* vb = sb + AT_KBYTES + r16 * AT_VPITCH + 2 * (koff + 8 * g4);
            if (__builtin_amdgcn_ballot_w64(alpha != 1.f) != 0ull) {
#pragma unroll
                for (int db = 0; db < 8; ++db) oacc[db] *= alpha;
            }
#pragma unroll
            for (int db = 0; db < 8; ++db) {
                const bf16x8 vf = *(const bf16x8*)(vb + 16 * db * AT_VPITCH);
                oacc[db] = __builtin_amdgcn_mfma_f32_16x16x32_bf16(vf, pf, oacc[db], 0, 0, 0);
            }
        };

        auto chunk2 = [&](const unsigned char* sb, int mode, int kpos0) {
            f32x4 sacc[2][2];
#pragma unroll
            for (int hf = 0; hf < 2; ++hf)
#pragma unroll
                for (int jb = 0; jb < 2; ++jb) {
                    const int kap = 32 * hf + 8 * (r16 >> 2) + 4 * jb + (r16 & 3);
                    const int swz = (kap & 3) | (((kap >> 3) & 3) << 2);
                    const unsigned char* kb = sb + kap * 256;
                    sacc[hf][jb] = (f32x4){0.f, 0.f, 0.f, 0.f};
#pragma unroll
                    for (int ks = 0; ks < 4; ++ks) {
                        const bf16x8 kf = *(const bf16x8*)(kb + 16 * ((4 * ks + g4) ^ swz));
                        sacc[hf][jb] = __builtin_amdgcn_mfma_f32_16x16x32_bf16(kf, qf[ks], sacc[hf][jb], 0, 0, 0);
                    }
                }
            float s[16];
#pragma unroll
            for (int hf = 0; hf < 2; ++hf)
#pragma unroll
                for (int jb = 0; jb < 2; ++jb)
#pragma unroll
                    for (int i = 0; i < 4; ++i) s[8 * hf + 4 * jb + i] = sacc[hf][jb][i] * SC2;
            if (mode == 2) {
                const int qpos = sw_q0 + r16;
#pragma unroll
                for (int hf = 0; hf < 2; ++hf)
#pragma unroll
                    for (int e = 0; e < 8; ++e) {
                        const int kpos = kpos0 + 32 * hf + 8 * g4 + e, d = kpos - qpos;
                        const bool valid = (kpos >= 0) && (kpos < SEQ) && (d <= 128) && (d >= -128);
                        s[8 * hf + e] = valid ? s[8 * hf + e] : NEG;
                    }
            }
            float cm = s[0];
#pragma unroll
            for (int e = 1; e < 16; ++e) cm = fmaxf(cm, s[e]);
            cm = fmaxf(cm, __shfl_xor(cm, 16)); cm = fmaxf(cm, __shfl_xor(cm, 32));
            const float m_new = fmaxf(m_run, cm);
            const float alpha = __builtin_amdgcn_exp2f(m_run - m_new);
            float pv[16], ps = 0.f;
#pragma unroll
            for (int e = 0; e < 16; ++e) { pv[e] = __builtin_amdgcn_exp2f(s[e] - m_new); ps += pv[e]; }
            l_run = l_run * alpha + ps; m_run = m_new;
            if (__builtin_amdgcn_ballot_w64(alpha != 1.f) != 0ull) {
#pragma unroll
                for (int db = 0; db < 8; ++db) oacc[db] *= alpha;
            }
#pragma unroll
            for (int hf = 0; hf < 2; ++hf) {
                u32x4 pw; pw.x = cvt_pk_bf16(pv[8 * hf], pv[8 * hf + 1]); pw.y = cvt_pk_bf16(pv[8 * hf + 2], pv[8 * hf + 3]); pw.z = cvt_pk_bf16(pv[8 * hf + 4], pv[8 * hf + 5]); pw.w = cvt_pk_bf16(pv[8 * hf + 6], pv[8 * hf + 7]);
                const bf16x8 pf = __builtin_bit_cast(bf16x8, pw);
                const unsigned char* vb = sb + AT_KBYTES + r16 * AT_VPITCH + 2 * (32 * hf + 8 * g4);
#pragma unroll
                for (int db = 0; db < 8; ++db) {
                    const bf16x8 vf = *(const bf16x8*)(vb + 16 * db * AT_VPITCH);
                    oacc[db] = __builtin_amdgcn_mfma_f32_16x16x32_bf16(vf, pf, oacc[db], 0, 0, 0);
                }
            }
        };

        stage_load(0);
        __syncthreads();
        stage_store(0);
        __syncthreads();
        for (int rd = 0; rd < nrounds; ++rd) {
            if (rd + 1 < nrounds) stage_load(rd + 1);
            const unsigned char* sb = lds + (rd & 1) * AT_STAGE;
            if (rd < 4) chunk2(sb, 0, 0);
            else if (type == 0) {
                const int kr = na_krlo + (rd - 4);
                if (kr >= na_kr0 && kr <= na_kr0 + 7) chunk(sb, na_kc0, 1, kr - na_r + 7, 0);
            } else {
                const int kp0 = sw_base + 64 * (rd - 4), kp1 = kp0 + 32;
                const bool a0 = (kp0 + 31 >= sw_q0 - 128) && (kp0 <= sw_q0 + 15 + 128) && (kp0 + 31 >= 0) && (kp0 < SEQ);
                const bool a1 = (kp1 + 31 >= sw_q0 - 128) && (kp1 <= sw_q0 + 15 + 128) && (kp1 + 31 >= 0) && (kp1 < SEQ);
                if (a0 && a1) chunk2(sb, 2, kp0);
                else if (a0) chunk(sb, 0, 2, 0, kp0);
                else if (a1) chunk(sb, 32, 2, 0, kp1);
            }
            if (rd + 1 < nrounds) stage_store((rd + 1) & 1);
            __syncthreads();
        }
        float lt = l_run; lt += __shfl_xor(lt, 16); lt += __shfl_xor(lt, 32);
        const float inv = 1.f / lt;
        bf16_t* op = O + (size_t)(qrow0 + r16) * DM + ocol + 4 * g4;
#pragma unroll
        for (int db = 0; db < 8; ++db) { const f32x4 v = oacc[db] * inv; u32x2 w; w.x = cvt_pk_bf16(v[0], v[1]); w.y = cvt_pk_bf16(v[2], v[3]); *(u32x2*)(op + 16 * db) = w; }
    }
}

__device__ __forceinline__ int s5_pair_of(int b) { const int x = b & 7, slot = b >> 3, lg = x * 4 + (slot >> 3), member = slot & 7; return (member >> 2) * 128 + lg * 4 + (member & 3); }
constexpr int S5_PITCH = 36, S5_WAVE_BYTES = 2 * 64 * S5_PITCH * 4, S5_SEG_OFF = 8 * S5_WAVE_BYTES, S5_SEG_BYTES = 8 * 64 * 8, XB_LDS_OFF = S5_SEG_OFF + S5_SEG_BYTES;
__device__ void s5_pass1(const Params& p, unsigned char* lds, const float2* segbase, int seg_pair_stride) {
    constexpr int pass = 1;
    const int lane = threadIdx.x & 63, seg = threadIdx.x >> 6;
    float* UR = (float*)(lds + seg * S5_WAVE_BYTES);
    float* UI = UR + 64 * S5_PITCH;
    const bf16_t* H = (const bf16_t*)(p.ws + OFF_H);
    const float2* LAM = (const float2*)(p.ws + OFF_LAM); const float2* LAML = (const float2*)(p.ws + OFF_LAML);
    const bf16_t* BBT = (const bf16_t*)(p.ws + OFF_BBT); const bf16_t* CCM = (const bf16_t*)(p.ws + OFF_CCM);
    const int l31 = lane & 31, h5 = lane >> 5, r16 = lane & 15, g4 = lane >> 4;
    for (int bi = blockIdx.x; bi < 256; bi += gridDim.x) {
        const int pr = s5_pair_of(bi);
        const float2* SEGS = segbase + (size_t)pr * seg_pair_stride;
        const int dir = pr >> 7, g = pr & 127;
        float* Y = (float*)(p.ws + (dir == 0 ? OFF_YF : OFF_YB));
        const float2 lam = LAM[pr * 64 + lane];
        bf16x8 bbf[4], ccf[4];
#pragma unroll
        for (int nb = 0; nb < 4; ++nb) bbf[nb] = *(const bf16x8*)(BBT + ((size_t)pr * 128 + 32 * nb + l31) * 16 + 8 * h5);
#pragma unroll
        for (int ks = 0; ks < 4; ++ks) ccf[ks] = *(const bf16x8*)(CCM + ((size_t)pr * 16 + r16) * 128 + 32 * ks + 8 * g4);
        float sr = 0.f, si = 0.f;
        if (pass == 1) {
            const float2 lL = LAML[pr * 64 + lane];
            for (int j = 0; j < seg; ++j) { const float2 e = SEGS[j * 64 + lane]; const float nr = lL.x * sr - lL.y * si + e.x, ni = lL.x * si + lL.y * sr + e.y; sr = nr; si = ni; }
        }
        auto load_x = [&](int tile) -> bf16x8 {
            const int i = (seg * SEG_TILES + tile) * 32 + l31;
            const int row = (dir == 0) ? i : ((i < 256) ? 255 - i : 8703 - i);
            return *(const bf16x8*)(H + (size_t)row * DM + 16 * g + 8 * h5);
        };
        bf16x8 xnext = load_x(0);
        for (int tile = 0; tile < SEG_TILES; ++tile) {
            const int i0 = (seg * SEG_TILES + tile) * 32;
            {
                const bf16x8 xf = xnext;
                xnext = load_x(min(tile + 1, SEG_TILES - 1));
#pragma unroll
                for (int nb = 0; nb < 4; ++nb) {
                    f32x16 z;
#pragma unroll
                    for (int q = 0; q < 16; ++q) z[q] = 0.f;
                    const f32x16 a = __builtin_amdgcn_mfma_f32_32x32x16_bf16(xf, bbf[nb], z, 0, 0, 0);
                    float* up = ((nb < 2) ? UR : UI) + (32 * (nb & 1) + l31) * S5_PITCH + 4 * h5;
#pragma unroll
                    for (int k = 0; k < 4; ++k) *(f32x4*)(up + 8 * k) = (f32x4){a[4 * k], a[4 * k + 1], a[4 * k + 2], a[4 * k + 3]};
                }
            }
            asm volatile("s_waitcnt lgkmcnt(0)" ::: "memory"); __builtin_amdgcn_wave_barrier();
#pragma unroll
            for (int t0 = 0; t0 < 32; t0 += 8) {
                const f32x4 ur0 = *(const f32x4*)(UR + lane * S5_PITCH + t0), ur1 = *(const f32x4*)(UR + lane * S5_PITCH + t0 + 4);
                const f32x4 ui0 = *(const f32x4*)(UI + lane * S5_PITCH + t0), ui1 = *(const f32x4*)(UI + lane * S5_PITCH + t0 + 4);
                const float urv[8] = {ur0[0], ur0[1], ur0[2], ur0[3], ur1[0], ur1[1], ur1[2], ur1[3]};
                const float uiv[8] = {ui0[0], ui0[1], ui0[2], ui0[3], ui1[0], ui1[1], ui1[2], ui1[3]};
                unsigned sp[8];
#pragma unroll
                for (int j = 0; j < 8; ++j) {
                    const float nr = fmaf(lam.x, sr, fmaf(-lam.y, si, urv[j])), ni = fmaf(lam.x, si, fmaf(lam.y, sr, uiv[j]));
                    sr = nr; si = ni;
                    if (pass == 1) sp[j] = cvt_pk_bf16(sr, si);
                }
                if (pass == 1) {
                    *(u32x4*)(UR + lane * S5_PITCH + t0) = (u32x4){sp[0], sp[1], sp[2], sp[3]};
                    *(u32x4*)(UR + lane * S5_PITCH + t0 + 4) = (u32x4){sp[4], sp[5], sp[6], sp[7]};
                }
            }
            asm volatile("s_waitcnt lgkmcnt(0)" ::: "memory"); __builtin_amdgcn_wave_barrier();
            if (pass == 1 && i0 >= 256) {
                const unsigned* S = (const unsigned*)UR;
#pragma unroll
                for (int mb = 0; mb < 2; ++mb) {
                    f32x4 acc = {0.f, 0.f, 0.f, 0.f};
                    const int t = 16 * mb + r16;
#pragma unroll
                    for (int ks = 0; ks < 4; ++ks) {
                        const unsigned* sp0 = S + (16 * ks + 4 * g4) * S5_PITCH + t;
                        u32x4 sw; sw.x = sp0[0]; sw.y = sp0[S5_PITCH]; sw.z = sp0[2 * S5_PITCH]; sw.w = sp0[3 * S5_PITCH];
                        acc = __builtin_amdgcn_mfma_f32_16x16x32_bf16(ccf[ks], __builtin_bit_cast(bf16x8, sw), acc, 0, 0, 0);
                    }
                    const int i = i0 + t;
                    const int row = (dir == 0) ? i : 8703 - i;
                    *(f32x4*)(Y + (size_t)(row - 256) * DM + 16 * g + 4 * g4) = acc;
                }
                asm volatile("s_waitcnt lgkmcnt(0)" ::: "memory"); __builtin_amdgcn_wave_barrier();
            }
        }
    }
}
__device__ void s5_pass0_reg(const Params& p, float2* segbase, int seg_pair_stride) {
    const int lane = threadIdx.x & 63, seg = threadIdx.x >> 6;
    const bf16_t* H = (const bf16_t*)(p.ws + OFF_H);
    const float2* LAMPOW = (const float2*)(p.ws + OFF_LAMPOW); const float2* LAM32 = (const float2*)(p.ws + OFF_LAM32);
    const bf16_t* BBT = (const bf16_t*)(p.ws + OFF_BBT);
    const int l31 = lane & 31, h5 = lane >> 5;
    for (int bi = blockIdx.x; bi < 256; bi += gridDim.x) {
        const int pr = s5_pair_of(bi);
        const int dir = pr >> 7, g = pr & 127;
        bf16x8 bbf[4];
#pragma unroll
        for (int nb = 0; nb < 4; ++nb) bbf[nb] = *(const bf16x8*)(BBT + ((size_t)pr * 128 + 32 * nb + l31) * 16 + 8 * h5);
        float2 pw[2][16], l32[2];
#pragma unroll
        for (int q = 0; q < 2; ++q) {
            const int pp = 32 * q + l31;
            l32[q] = LAM32[pr * 64 + pp];
#pragma unroll
            for (int r = 0; r < 16; ++r) { const int t = (r & 3) + 8 * (r >> 2) + 4 * h5; pw[q][r] = LAMPOW[((size_t)pr * 64 + pp) * 32 + (31 - t)]; }
        }
        float sr[2] = {0.f, 0.f}, si[2] = {0.f, 0.f};
        auto load_x = [&](int tile) -> bf16x8 {
            const int i = (seg * SEG_TILES + tile) * 32 + l31;
            const int row = (dir == 0) ? i : ((i < 256) ? 255 - i : 8703 - i);
            return *(const bf16x8*)(H + (size_t)row * DM + 16 * g + 8 * h5);
        };
        bf16x8 xnext = load_x(0);
        for (int tile = 0; tile < SEG_TILES; ++tile) {
            const bf16x8 xf = xnext;
            xnext = load_x(min(tile + 1, SEG_TILES - 1));
#pragma unroll
            for (int q = 0; q < 2; ++q) {
                f32x16 z;
#pragma unroll
                for (int r = 0; r < 16; ++r) z[r] = 0.f;
                const f32x16 are = __builtin_amdgcn_mfma_f32_32x32x16_bf16(xf, bbf[q], z, 0, 0, 0);
                const f32x16 aim = __builtin_amdgcn_mfma_f32_32x32x16_bf16(xf, bbf[q + 2], z, 0, 0, 0);
                float er0 = 0.f, ei0 = 0.f, er1 = 0.f, ei1 = 0.f;
#pragma unroll
                for (int r = 0; r < 16; r += 2) {
                    er0 = fmaf(pw[q][r].x, are[r], fmaf(-pw[q][r].y, aim[r], er0)); ei0 = fmaf(pw[q][r].x, aim[r], fmaf(pw[q][r].y, are[r], ei0));
                    er1 = fmaf(pw[q][r + 1].x, are[r + 1], fmaf(-pw[q][r + 1].y, aim[r + 1], er1)); ei1 = fmaf(pw[q][r + 1].x, aim[r + 1], fmaf(pw[q][r + 1].y, are[r + 1], ei1));
                }
                float er = er0 + er1, ei = ei0 + ei1;
                er += __shfl_xor(er, 32); ei += __shfl_xor(ei, 32);
                const float nr = fmaf(l32[q].x, sr[q], fmaf(-l32[q].y, si[q], er)), ni = fmaf(l32[q].x, si[q], fmaf(l32[q].y, sr[q], ei));
                sr[q] = nr; si[q] = ni;
            }
        }
        if (h5 == 0) {
            float2* SEGL = segbase + (size_t)pr * seg_pair_stride;
            SEGL[seg * 64 + l31] = make_float2(sr[0], si[0]);
            SEGL[seg * 64 + 32 + l31] = make_float2(sr[1], si[1]);
        }
    }
}
__device__ void s5_combine(const Params& p) {
    const bf16_t* H = (const bf16_t*)(p.ws + OFF_H) + (size_t)256 * DM;
    const float* YF = (const float*)(p.ws + OFF_YF); const float* YB = (const float*)(p.ws + OFF_YB);
    bf16_t* AG = (bf16_t*)(p.ws + OFF_AG);
    const size_t n4 = (size_t)SEQ * DM / 4, stride = (size_t)gridDim.x * 512;
    for (size_t i = (size_t)blockIdx.x * 512 + threadIdx.x; i < n4; i += stride) {
        const int col = (int)((i * 4) & (DM - 1));
        const u32x2 hv = *(const u32x2*)(H + i * 4);
        const f32x4 yf = *(const f32x4*)(YF + i * 4), yb = *(const f32x4*)(YB + i * 4), dv = *(const f32x4*)(p.ssm_d + col);
        float hx[4] = {bf16_lo(hv.x), bf16_hi(hv.x), bf16_lo(hv.y), bf16_hi(hv.y)}, o[4];
#pragma unroll
        for (int j = 0; j < 4; ++j) {
            const float y = dv[j] * hx[j] + yf[j] + yb[j];
            const float z = 0.7978845608028654f * (y + 0.044715f * y * y * y);
            const float th = 1.f - 2.f * __builtin_amdgcn_rcpf(1.f + __expf(2.f * z));
            o[j] = 0.5f * y * (1.f + th);
        }
        u32x2 w; w.x = cvt_pk_bf16(o[0], o[1]); w.y = cvt_pk_bf16(o[2], o[3]);
        *(u32x2*)(AG + i * 4) = w;
    }
}

__device__ __forceinline__ void ffn_block(const Params& p, const int layer, LAS unsigned char* ldsl, const XcdBarrier& xbar) {
    unsigned char* ws = p.ws;
    const int G = gridDim.x, cid = blockIdx.x;
    const float* modl = (const float*)(ws + OFF_MOD) + (size_t)layer * 2 * 12288;
    bf16_t* H = (bf16_t*)(ws + OFF_H); bf16_t* U = (bf16_t*)(ws + OFF_U);
    float* XA = (float*)(ws + OFF_XA); float* XB = (float*)(ws + OFF_XB); float* PART = (float*)(ws + OFF_PART);
    const int r0 = (layer == 0) ? 0 : 256, Mf = MROWS - r0;
    if (layer == 1) {
        norm_phase(p.ctx, XA + (size_t)256 * DM, r0, MROWS, p.norm_ffn + (size_t)layer * DM, modl, 4, 3, H, nullptr, 0, nullptr);
        xcd_barrier(xbar);
    }
    { pg8::Gemm g{H + (size_t)r0 * DM, (const bf16_t*)(ws + OFF_W13) + (size_t)layer * 2 * DFF * DM, Mf, 2 * DFF, DM}; pg8::StaticOrder S; S.init(Mf, 2 * DFF, DM, G, cid);
      EpiSwiGLU E{U + (size_t)r0 * DFF};
      const int full = (S.nwg / G) * G, rem = S.nwg - full;
      const bool tail = (layer == 1) && rem > 0 && 2 * rem <= G;
      if (tail) S.lim = full;
      pg8::gemm_phase<EpiSwiGLU, pg8::StaticOrder, true, true>(ldsl, g, S, E);
      if (layer == 1) { if (tail) {
          pg8::OneUnit T; T.so = S; T.L = (cid < 2 * rem) ? full + (cid >> 1) : -1; T.half = 1 + (cid & 1);
          if (cid & 1) pg8::gemm_phase<EpiSwiGLU, pg8::OneUnit, false, true, 2>(ldsl, g, T, E);
          else         pg8::gemm_phase<EpiSwiGLU, pg8::OneUnit, false, true, 1>(ldsl, g, T, E);
      } } }
    if (layer == 0) {
        const bool all = (G != 256);
        if (all || cid >= 172) ada_gemv(p, (unsigned char*)ldsl, 256, 512, all ? cid : cid - 172, all ? G : 84);
    }
    xcd_barrier(xbar);
    { pg8::Gemm g{U + (size_t)r0 * DFF, (const bf16_t*)(ws + OFF_W2) + (size_t)layer * DM * DFF, Mf, DM, DFF};
      if (layer == 0) {
          const float* modl1 = modl + 2 * 12288;
          pg8::CtxSplitOrder S; S.init(DM, DFF, G, cid);
          EpiResNormH E{XA + (size_t)256 * DM, modl + 12288 + 5 * DM, modl + 5 * DM, XB, PART, (float*)(ws + OFF_SSP), p.norm_mix + DM, modl1 + 1 * DM, modl1, H, &xbar};
          pg8::gemm_phase<EpiResNormH, pg8::CtxSplitOrder, false, true>(ldsl, g, S, E);
          norm_phase(XA, nullptr, 0, 256, p.norm_mix + DM, modl1, 1, 0, H, PART, 22, nullptr);
      }
      else {
          pg8::StaticOrder S; S.init(Mf, DM, DFF, G, cid);
          EpiResNorm EN{XA + (size_t)256 * DM, modl + 5 * DM, p.norm_final, p.out, PART, &xbar}; pg8::gemm_phase<EpiResNorm, pg8::StaticOrder, false, true>(ldsl, g, S, EN); } }
    if (layer == 0) xcd_barrier(xbar);
}

__global__ void __launch_bounds__(512, 2) fwd_megakernel(Params p) {
    extern __shared__ __attribute__((aligned(16))) unsigned char lds[];
    cg::grid_group grid = cg::this_grid();
    if (threadIdx.x == 0) *(uint4*)(lds + XB_LDS_OFF) = make_uint4(0u, 0u, 0u, 0u);
    __syncthreads();
    const XcdBarrier xbar = xcd_barrier_post((unsigned*)(p.ws + OFF_BAR), (volatile LAS unsigned*)((LAS unsigned char*)lds + XB_LDS_OFF));
    LAS unsigned char* ldsl = (LAS unsigned char*)lds;
    unsigned char* ws = p.ws;
    const int G = gridDim.x, cid = blockIdx.x;
    float* MOD = (float*)(ws + OFF_MOD);
    bf16_t* H = (bf16_t*)(ws + OFF_H); bf16_t* U = (bf16_t*)(ws + OFF_U);
    float* XA = (float*)(ws + OFF_XA); float* XB = (float*)(ws + OFF_XB); float* PART = (float*)(ws + OFF_PART);

#ifndef NO_P0
    p0_prologue(p, lds);
#endif
    if (p.ws == nullptr) grid.sync();
    xcd_barrier(xbar);

    {
        const float* modl = MOD;
        norm_phase(p.ctx, p.x, 0, MROWS, p.norm_mix, modl, 1, 0, H, nullptr, 0, nullptr);
        xcd_barrier(xbar);
        { pg8::Gemm g{H, (const bf16_t*)(ws + OFF_WQK), MROWS, NQK, DM}; pg8::StaticOrder S; S.init(MROWS, NQK, DM, G, cid);
          EpiQK E{(bf16_t*)(ws + OFF_QK), (const float2*)(ws + OFF_ROPE)}; pg8::gemm_phase<EpiQK, pg8::StaticOrder, true, true>(ldsl, g, S, E); }
        { pg8::Gemm g{(const bf16_t*)(ws + OFF_WV), H, NV, MROWS, DM}; pg8::StaticOrder S; S.init(NV, MROWS, DM, G, G - 1 - cid);
          EpiBf16Plain E{(bf16_t*)(ws + OFF_VT), MROWS}; pg8::gemm_phase<EpiBf16Plain, pg8::StaticOrder, true, true>(ldsl, g, S, E); }
        {
            const bool three = (G == 256) && (cid >= 91) && (cid < 173);
            if (!three) conv_tiles(p, CONV_L0_TILES, CONV_ALL_TILES, (G == 256) ? ((cid < 91) ? cid : cid - 82) : cid, (G == 256) ? 174 : G);
        }
        xcd_barrier(xbar);
#ifndef NO_ATTN
        attn_phase(p, lds);
#endif
        xcd_barrier(xbar);
        {
            pg8::Gemm g{(const bf16_t*)(ws + OFF_O), (const bf16_t*)(ws + OFF_WO), MROWS, DM, DM}; pg8::CtxSplitOrder S; S.init(DM, DM, G, cid);
            EpiResNormH E{p.x, modl + 12288 + 2 * DM, modl + 2 * DM, XA, PART, (float*)(ws + OFF_SSP), p.norm_ffn, modl + 4 * DM, modl + 3 * DM, H, &xbar};
            pg8::gemm_phase<EpiResNormH, pg8::CtxSplitOrder, false, true>(ldsl, g, S, E);
            norm_phase(p.ctx, nullptr, 0, 256, p.norm_ffn, modl, 4, 3, H, PART, 8, XA);
        }
        xcd_barrier(xbar);
        ffn_block(p, 0, ldsl, xbar);
    }
    {
        const float* modl = MOD + 2 * 12288;
        {
            const bool one = gridDim.x >= 256;
            float2* segbase = one ? (float2*)(lds + S5_SEG_OFF) : (float2*)(ws + OFF_SEG);
            const int sstride = one ? 0 : 512;
            s5_pass0_reg(p, segbase, sstride);
            if (one) __syncthreads(); else xcd_barrier(xbar);
            s5_pass1(p, lds, segbase, sstride);
        }
        xcd_barrier(xbar);
        s5_combine(p);
        xcd_barrier(xbar);
        { pg8::Gemm g{(const bf16_t*)(ws + OFF_AG), (const bf16_t*)(ws + OFF_WGLU), SEQ, 4096, DM}; pg8::StaticOrder S; S.init(SEQ, 4096, DM, G, cid);
          EpiGLU E{XB + (size_t)256 * DM, XA + (size_t)256 * DM, modl + 2 * DM, p.b_glu}; pg8::gemm_phase<EpiGLU, pg8::StaticOrder, true, true>(ldsl, g, S, E); }
        xcd_barrier(xbar);
        ffn_block(p, 1, ldsl, xbar);
    }
}

extern "C" void kernel_launch(void* const* d_in, const int* in_sizes, int n_in, void* d_out, int out_size, void* d_ws, size_t ws_size, hipStream_t stream) {
    constexpr int kDynLds = 8 * S5_WAVE_BYTES + S5_SEG_BYTES + 16;
    static_assert(kDynLds >= pg8::STAGE_BYTES, "LDS");
    static int grid_blocks = 0;
    if (!grid_blocks) {
        int dev = 0, cus = 0, per_cu = 0;
        hipGetDevice(&dev);
        hipDeviceGetAttribute(&cus, hipDeviceAttributeMultiprocessorCount, dev);
        hipFuncSetAttribute((const void*)fwd_megakernel, hipFuncAttributeMaxDynamicSharedMemorySize, kDynLds);
        hipOccupancyMaxActiveBlocksPerMultiprocessor(&per_cu, (const void*)fwd_megakernel, 512, kDynLds);
        if (per_cu < 1) { fprintf(stderr, "occupancy query returned %d\n", per_cu); per_cu = 1; }
        if (per_cu > 1) per_cu = 1;
        grid_blocks = cus * per_cu;
        if (grid_blocks > 256) grid_blocks = 256;
        if (grid_blocks != 256) fprintf(stderr, "this kernel is specialised for a 256-workgroup grid (got %d)\n", grid_blocks);
        if (ws_size < WS_END) fprintf(stderr, "workspace too small: %zu < %zu\n", ws_size, (size_t)WS_END);
    }
    Params p{};
    const float* const* in = (const float* const*)d_in;
    p.x = in[0]; p.c = in[1]; p.ctx = in[2]; p.c_ctx = in[3]; p.ada_w = in[4]; p.ada_b = in[5];
    p.norm_mix = in[6]; p.norm_ffn = in[7]; p.w1 = in[8]; p.w3 = in[9]; p.w2 = in[10];
    p.w_in = in[11]; p.w_out = in[12]; p.rpb = in[13]; p.sink = in[14];
    p.a_re = in[15]; p.a_im = in[16]; p.log_dt = in[17]; p.b_re = in[18]; p.b_im = in[19]; p.c_re = in[20]; p.c_im = in[21];
    p.ssm_d = in[22]; p.w_glu = in[23]; p.b_glu = in[24]; p.norm_final = in[25];
    p.out = (float*)d_out; p.ws = (unsigned char*)d_ws;
    hipMemsetAsync((unsigned char*)d_ws + OFF_BAR, 0, BAR_BYTES, stream);
    void* args[] = {&p};
    hipError_t e = hipLaunchCooperativeKernel((const void*)fwd_megakernel, dim3(grid_blocks), dim3(512), args, kDynLds, stream);
    if (e != hipSuccess) fprintf(stderr, "cooperative launch failed: %s (grid %d)\n", hipGetErrorString(e), grid_blocks);
}
```
